# Optimizing an MI355X kernel written in HIP

```python
import math
import jax, jax.numpy as jnp
from jax import lax
import numpy as np

D_MODEL = 1024
BATCH = 8
SEQ = 2048
DEPTH = 4

GRID_W = 64
CTX_LEN = 256
N_MIXERS = 2
N_MLSTM_LAYERS = (DEPTH + 1) // 2
N_RGLRU_LAYERS = DEPTH // 2
M_HEADS = 8
M_DQK = 64
M_DV = 128
M_CHUNK = 64
M_PROJ = 2 * M_HEADS * M_DQK + 2 * M_HEADS * M_DV + 4 * M_HEADS
R_WIDTH = D_MODEL
R_BLOCKS = 8
R_BW = R_WIDTH // R_BLOCKS
R_CONV = 4
R_C = 8.0
N_EXPERTS = 16
N_GROUPS = 4
EXPERTS_PER_GROUP = N_EXPERTS // N_GROUPS
TOP_K = 2
D_EXPERT = 512
EPS = 1e-6
POS_BASE = 10000.0

kernel_name = "hybrid_mlstm_rglru_moe_prefix_dit"

F32 = jnp.float32


def rmsnorm(x, g):
    x32 = x.astype(F32)
    y = x32 * lax.rsqrt(jnp.mean(x32 * x32, axis=-1, keepdims=True) + EPS) * g.astype(F32)
    return y.astype(x.dtype)


def modulate(x, g, shift, scale):
    return rmsnorm(x, g) * (1 + scale) + shift


def pos_embed_2d(n_tokens, dim, dtype):
    rows = n_tokens // GRID_W
    r, col = jnp.meshgrid(jnp.arange(rows, dtype=F32), jnp.arange(GRID_W, dtype=F32), indexing='ij')
    quarter = dim // 4
    freqs = jnp.exp(-math.log(POS_BASE) * jnp.arange(quarter, dtype=F32) / quarter)
    def enc(p):
        ang = p.reshape(-1, 1) * freqs
        return jnp.concatenate([jnp.sin(ang), jnp.cos(ang)], axis=-1)
    return jnp.concatenate([enc(r), enc(col)], axis=-1).astype(dtype)


def mlstm_chunkwise(q, k, v, ig, lf, state):
    bsz, nh, t, _ = q.shape
    nc = t // M_CHUNK
    def chunks(a):
        a = a.reshape(bsz, nh, nc, M_CHUNK, *a.shape[3:])
        return jnp.moveaxis(a, 2, 0)
    causal = jnp.tril(jnp.ones((M_CHUNK, M_CHUNK), dtype=bool))
    def step(carry, inp):
        C, n, m = carry
        qc, kc, vc, ic, fc = inp
        b = jnp.cumsum(fc, axis=-1)
        logd = jnp.where(causal, b[..., :, None] - b[..., None, :] + ic[..., None, :], -jnp.inf)
        log_inter = b + m[..., None]
        m_pos = jnp.maximum(log_inter, jnp.max(logd, axis=-1))
        w_intra = jnp.exp(logd - m_pos[..., None])
        w_inter = jnp.exp(log_inter - m_pos)
        s = jnp.einsum('bhjd,bhsd->bhjs', qc, kc) * w_intra
        num = jnp.einsum('bhjs,bhsv->bhjv', s, vc) + w_inter[..., None] * jnp.einsum('bhjd,bhdv->bhjv', qc, C)
        den = jnp.sum(s, axis=-1) + w_inter * jnp.einsum('bhjd,bhd->bhj', qc, n)
        h = num / jnp.maximum(jnp.abs(den), jnp.exp(-m_pos))[..., None]
        m_new = m_pos[..., -1]
        w_s = jnp.exp(b[..., -1:] - b + ic - m_new[..., None])
        decay = jnp.exp(b[..., -1] + m - m_new)
        C_new = decay[..., None, None] * C + jnp.einsum('bhs,bhsd,bhsv->bhdv', w_s, kc, vc)
        n_new = decay[..., None] * n + jnp.einsum('bhs,bhsd->bhd', w_s, kc)
        return (C_new, n_new, m_new), h
    state, h = lax.scan(step, state, (chunks(q), chunks(k), chunks(v), chunks(ig), chunks(lf)))
    h = jnp.moveaxis(h, 0, 2).reshape(bsz, nh, t, -1)
    return h, state


def mlstm_mixer(hl, hc, w_in, b_gate, g_head, w_out, ctx_out):
    split_at = [M_HEADS * M_DQK, 2 * M_HEADS * M_DQK, 2 * M_HEADS * M_DQK + M_HEADS * M_DV,
                2 * M_HEADS * M_DQK + 2 * M_HEADS * M_DV]
    def project(h):
        bsz, t, _ = h.shape
        p = jnp.einsum('btd,dp->btp', h, w_in).astype(F32)
        q, k, v, o, g = jnp.split(p, split_at, axis=-1)
        heads = lambda a: a.reshape(bsz, t, M_HEADS, -1).transpose(0, 2, 1, 3)
        g = g.reshape(bsz, t, 4, M_HEADS).transpose(2, 0, 3, 1) + b_gate.astype(F32)[:, None, :, None]
        return (heads(q) * (M_DQK ** -0.5), heads(k), heads(v), jax.nn.sigmoid(o),
                g[0], jax.nn.log_sigmoid(g[1]), g[2], jax.nn.log_sigmoid(g[3]))
    flip = lambda a: jnp.flip(a, axis=2)
    def bidir(q, k, v, i_f, lf_f, i_b, lf_b, st_f, st_b):
        h_f, st_f = mlstm_chunkwise(q, k, v, i_f, lf_f, st_f)
        h_b, st_b = mlstm_chunkwise(flip(q), flip(k), flip(v), flip(i_b), flip(lf_b), st_b)
        return h_f + flip(h_b), st_f, st_b
    def readout(h, o, dtype):
        bsz, _, t, _ = h.shape
        h = h * lax.rsqrt(jnp.mean(h * h, axis=-1, keepdims=True) + EPS)
        h = h.transpose(0, 2, 1, 3).reshape(bsz, t, M_HEADS * M_DV) * g_head.astype(F32) * o
        return jnp.einsum('bte,ed->btd', h.astype(dtype), w_out).astype(dtype)
    qc, kc, vc, oc, icf, lfcf, icb, lfcb = project(hc)
    bsz = hc.shape[0]
    zero = (jnp.zeros((bsz, M_HEADS, M_DQK, M_DV), F32), jnp.zeros((bsz, M_HEADS, M_DQK), F32),
            jnp.zeros((bsz, M_HEADS), F32))
    hc_sum, st_f, st_b = bidir(qc, kc, vc, icf, lfcf, icb, lfcb, zero, zero)
    ql, kl, vl, ol, ilf, lflf, ilb, lflb = project(hl)
    hl_sum, _, _ = bidir(ql, kl, vl, ilf, lflf, ilb, lflb, st_f, st_b)
    out_l = readout(hl_sum, ol, hl.dtype)
    out_c = readout(hc_sum, oc, hc.dtype) if ctx_out else None
    return out_l, out_c


def centred_dwconv(x, w, b):
    t = x.shape[1]
    left = R_CONV // 2
    xp = jnp.pad(x, ((0, 0), (left, R_CONV - 1 - left), (0, 0)))
    y = b + xp[:, 0:t] * w[0]
    for j in range(1, R_CONV):
        y = y + xp[:, j:j + t] * w[j]
    return y


def _lru_combine(left, right):
    a1, b1 = left
    a2, b2 = right
    return a1 * a2, a2 * b1 + b2


def lru_scan(a, bx, h0, reverse):
    edge = -1 if reverse else 0
    bx = bx.at[:, edge].add(a[:, edge] * h0)
    _, h = lax.associative_scan(_lru_combine, (a, bx), reverse=reverse, axis=1)
    return h


def rglru_mixer(hl, hc, w_in, conv_w, conv_b, w_gate, b_gate, lam, w_out, ctx_out):
    def branches(h):
        p = jnp.einsum('btd,de->bte', h, w_in)
        y, xr = jnp.split(p, 2, axis=-1)
        return y, centred_dwconv(xr, conv_w, conv_b).astype(F32)
    def gates(xr, d):
        bsz, t, _ = xr.shape
        xb = xr.reshape(bsz, t, R_BLOCKS, R_BW)
        g = jnp.einsum('btnd,nde->btne', xb, w_gate[d].astype(F32)) + b_gate[d].astype(F32)
        r = jax.nn.sigmoid(g[..., :R_BW]).reshape(bsz, t, R_WIDTH)
        i = jax.nn.sigmoid(g[..., R_BW:]).reshape(bsz, t, R_WIDTH)
        log_a = -R_C * r * jax.nn.softplus(-lam[d].astype(F32))
        a = jnp.exp(log_a)
        return a, jnp.sqrt(-jnp.expm1(2.0 * log_a)) * (i * xr)
    def readout(y, h, dtype):
        return jnp.einsum('bte,ed->btd', (jax.nn.gelu(y.astype(F32)) * h).astype(dtype), w_out).astype(dtype)
    yc, xcr = branches(hc)
    yl, xlr = branches(hl)
    h0 = jnp.zeros((hc.shape[0], R_WIDTH), F32)
    a, bx = gates(xcr, 0)
    hc_f = lru_scan(a, bx, h0, False)
    a, bx = gates(xcr, 1)
    hc_b = lru_scan(a, bx, h0, True)
    a, bx = gates(xlr, 0)
    hl_f = lru_scan(a, bx, hc_f[:, -1], False)
    a, bx = gates(xlr, 1)
    hl_b = lru_scan(a, bx, hc_b[:, 0], True)
    out_l = readout(yl, hl_f + hl_b, hl.dtype)
    out_c = readout(yc, hc_f + hc_b, hc.dtype) if ctx_out else None
    return out_l, out_c


def moe(h, w_router, b_router, w1, w3, w2):
    logits = jnp.einsum('bnd,de->bne', h.astype(F32), w_router.astype(F32))
    scores = jax.nn.softmax(logits, axis=-1)
    sel = scores + b_router.astype(F32)
    bsz, n, _ = sel.shape
    grp = sel.reshape(bsz, n, N_GROUPS, EXPERTS_PER_GROUP)
    grp_score = jnp.sum(lax.top_k(grp, TOP_K)[0], axis=-1)
    g_idx = jnp.argmax(grp_score, axis=-1)
    in_grp = (jnp.arange(N_EXPERTS) // EXPERTS_PER_GROUP) == g_idx[..., None]
    _, top_idx = lax.top_k(jnp.where(in_grp, sel, -jnp.inf), TOP_K)
    top_w = jnp.take_along_axis(scores, top_idx, axis=-1)
    top_w = top_w / jnp.sum(top_w, axis=-1, keepdims=True)
    gate = jnp.einsum('bnk,bnke->bne', top_w, jax.nn.one_hot(top_idx, N_EXPERTS, dtype=F32))
    y = jnp.zeros(h.shape, F32)
    for e in range(N_EXPERTS):
        u = jax.nn.silu(h @ w1[e]) * (h @ w3[e])
        y = y + gate[..., e:e + 1] * (u @ w2[e]).astype(F32)
    return y.astype(h.dtype)


def setup_inputs(seed: int = 0) -> dict:
    key = jax.random.key(seed)
    ks = jax.random.split(key, 25)
    nrm = lambda k, shape, scale: jax.random.normal(k, shape, F32) * scale
    D = D_MODEL
    f_base = 3.0 + 3.0 * jnp.linspace(0.0, 1.0, M_HEADS)
    zh = jnp.zeros((M_HEADS,), F32)
    gate_base = jnp.stack([zh, f_base, zh, f_base])
    u = jax.random.uniform(ks[18], (N_RGLRU_LAYERS, 2, R_WIDTH), F32, minval=0.9, maxval=0.999)
    return {
        "x": nrm(ks[0], (BATCH, SEQ, D), 1.0),
        "c": nrm(ks[1], (BATCH, D), 1.0),
        "ctx": nrm(ks[2], (BATCH, CTX_LEN, D), 1.0),
        "c_ctx": nrm(ks[3], (D,), 1.0),
        "w_ada": nrm(ks[4], (DEPTH, D, 6 * D), 0.5 * D ** -0.5),
        "b_ada": nrm(ks[5], (DEPTH, 6 * D), 0.02),
        "g_mix": 1.0 + nrm(ks[6], (DEPTH, D), 0.02),
        "g_ffn": 1.0 + nrm(ks[7], (DEPTH, D), 0.02),
        "g_final": 1.0 + nrm(ks[8], (D,), 0.02),
        "m_w_in": nrm(ks[9], (N_MLSTM_LAYERS, D, M_PROJ), D ** -0.5),
        "m_b_gate": gate_base[None] + nrm(ks[10], (N_MLSTM_LAYERS, 4, M_HEADS), 0.1),
        "m_g_head": 1.0 + nrm(ks[11], (N_MLSTM_LAYERS, M_HEADS * M_DV), 0.02),
        "m_w_out": nrm(ks[12], (N_MLSTM_LAYERS, M_HEADS * M_DV, D), (M_HEADS * M_DV) ** -0.5),
        "r_w_in": nrm(ks[13], (N_RGLRU_LAYERS, D, 2 * R_WIDTH), D ** -0.5),
        "r_conv_w": nrm(ks[14], (N_RGLRU_LAYERS, R_CONV, R_WIDTH), R_CONV ** -0.5),
        "r_conv_b": nrm(ks[15], (N_RGLRU_LAYERS, R_WIDTH), 0.02),
        "r_w_gate": nrm(ks[16], (N_RGLRU_LAYERS, 2, R_BLOCKS, R_BW, 2 * R_BW), R_BW ** -0.5),
        "r_b_gate": nrm(ks[17], (N_RGLRU_LAYERS, 2, R_BLOCKS, 2 * R_BW), 0.02),
        "r_lam": jnp.log(u) - jnp.log1p(-u),
        "r_w_out": nrm(ks[19], (N_RGLRU_LAYERS, R_WIDTH, D), R_WIDTH ** -0.5),
        "w_router": nrm(ks[20], (D, N_EXPERTS), D ** -0.5),
        "b_router": nrm(ks[21], (N_EXPERTS,), 0.01),
        "e_w1": nrm(ks[22], (DEPTH, N_EXPERTS, D, D_EXPERT), D ** -0.5),
        "e_w3": nrm(ks[23], (DEPTH, N_EXPERTS, D, D_EXPERT), D ** -0.5),
        "e_w2": nrm(ks[24], (DEPTH, N_EXPERTS, D_EXPERT, D), D_EXPERT ** -0.5),
    }


def reference(x, c, ctx, c_ctx, w_ada, b_ada, g_mix, g_ffn, g_final,
              m_w_in, m_b_gate, m_g_head, m_w_out,
              r_w_in, r_conv_w, r_conv_b, r_w_gate, r_b_gate, r_lam, r_w_out,
              w_router, b_router, e_w1, e_w3, e_w2):
    xl = x + pos_embed_2d(x.shape[1], x.shape[2], x.dtype)[None]
    xc = ctx
    silu_l = jax.nn.silu(c)[:, None, :]
    silu_c = jax.nn.silu(c_ctx)[None, None, :]
    for i in range(DEPTH):
        last = i == DEPTH - 1
        mod_l = jnp.split(silu_l @ w_ada[i] + b_ada[i], 6, axis=-1)
        mod_c = jnp.split(silu_c @ w_ada[i] + b_ada[i], 6, axis=-1)
        hl = modulate(xl, g_mix[i], mod_l[0], mod_l[1])
        hc = modulate(xc, g_mix[i], mod_c[0], mod_c[1])
        j = i // N_MIXERS
        if i % N_MIXERS == 0:
            ol, oc = mlstm_mixer(hl, hc, m_w_in[j], m_b_gate[j], m_g_head[j], m_w_out[j], not last)
        else:
            ol, oc = rglru_mixer(hl, hc, r_w_in[j], r_conv_w[j], r_conv_b[j], r_w_gate[j],
                                 r_b_gate[j], r_lam[j], r_w_out[j], not last)
        xl = xl + mod_l[2] * ol
        hl = modulate(xl, g_ffn[i], mod_l[3], mod_l[4])
        xl = xl + mod_l[5] * moe(hl, w_router, b_router, e_w1[i], e_w3[i], e_w2[i])
        if not last:
            xc = xc + mod_c[2] * oc
            hc = modulate(xc, g_ffn[i], mod_c[3], mod_c[4])
            xc = xc + mod_c[5] * moe(hc, w_router, b_router, e_w1[i], e_w3[i], e_w2[i])
    return rmsnorm(xl, g_final)
```

```cpp
#ifndef HOST_EMU
#include <hip/hip_runtime.h>
#include <cstdio>
#include <cstdint>
#define HD __device__ __forceinline__
#define DEV __device__ __forceinline__
#else
#include <cmath>
#include <cstdio>
#include <cstdint>
#include <cstring>
#define HD inline
#define DEV inline
#endif

#ifndef CFG_D
#define CFG_D 1024
#define CFG_B 8
#define CFG_SEQ 2048
#define CFG_CTX 256
#define CFG_DQK 64
#define CFG_DV 128
#define CFG_DE 512
#endif
constexpr int D = CFG_D, NB = CFG_B, SEQ = CFG_SEQ, CTX = CFG_CTX, DEPTH = 4, NH = 8, DQK = CFG_DQK, DV = CFG_DV, NE = 16, DE = CFG_DE;
constexpr int S = CTX + SEQ;
constexpr int MROWS = NB * S;
constexpr int QKW = NH * DQK, VW = NH * DV, MPROJ = 2 * QKW + 2 * VW + 4 * NH;
constexpr int MPROJ_P = (MPROJ + 255) / 256 * 256;
constexpr int RBW = D / 8;
constexpr int G13 = DE < 128 ? DE : 128;
constexpr int GRIDW = 64;
constexpr float EPS = 1e-6f;
constexpr int UROWS = 2 * MROWS + NE * 256;

typedef unsigned short bf16;
HD unsigned f2u(float f) { unsigned u; memcpy(&u, &f, 4); return u; }
HD float u2f(unsigned u) { float f; memcpy(&f, &u, 4); return f; }
HD bf16 f2bf(float f) { unsigned u = f2u(f); u += 0x7FFFu + ((u >> 16) & 1u); return (bf16)(u >> 16); }
HD float bf2f(bf16 b) { return u2f(((unsigned)b) << 16); }
HD float sigmoidf_(float x) { return 1.0f / (1.0f + expf(-x)); }
HD float siluf_(float x) { return x / (1.0f + expf(-x)); }
HD float logsigmoidf_(float x) { return x >= 0.f ? -log1pf(expf(-x)) : x - log1pf(expf(x)); }
HD float softplusf_(float x) { return x > 0.f ? x + log1pf(expf(-x)) : log1pf(expf(x)); }
HD float geluf_(float x) { return 0.5f * x * (1.0f + tanhf(0.7978845608028654f * (x + 0.044715f * x * x * x))); }

constexpr size_t al256(size_t x) { return (x + 255) / 256 * 256; }
constexpr size_t WS_CTL = 0, CTL_BYTES = 1u << 20;
constexpr size_t WS_MOD = WS_CTL + CTL_BYTES;
constexpr size_t WS_SIL = WS_MOD + al256((size_t)DEPTH * (NB + 1) * 6 * D * 4);
constexpr size_t WS_WINM = WS_SIL + al256((size_t)(NB + 1) * D * 4);
constexpr size_t WS_WOUTM = WS_WINM + al256((size_t)2 * MPROJ_P * D * 2);
constexpr size_t WS_WINR = WS_WOUTM + al256((size_t)2 * D * VW * 2);
constexpr size_t WS_WOUTR = WS_WINR + al256((size_t)2 * 2 * D * D * 2);
constexpr size_t WS_WG = WS_WOUTR + al256((size_t)2 * D * D * 2);
constexpr size_t WS_W13 = WS_WG + al256((size_t)2 * 2 * 8 * 2 * RBW * RBW * 2);
constexpr size_t WS_W2 = WS_W13 + al256((size_t)DEPTH * NE * 2 * DE * D * 2);
constexpr size_t WS_X = WS_W2 + al256((size_t)DEPTH * NE * D * DE * 2);
constexpr size_t WS_HB = WS_X + al256((size_t)MROWS * D * 4);
constexpr size_t WS_RB = WS_HB + al256((size_t)MROWS * D * 2);
constexpr int RBK = VW > D ? VW : D;
constexpr size_t WS_GT = WS_RB + al256((size_t)MROWS * RBK * 2);
constexpr size_t WS_RTE = WS_GT + al256((size_t)MROWS * 4 * NH * 4);
constexpr size_t WS_RTW = WS_RTE + al256((size_t)MROWS * 2 * 4);
constexpr size_t WS_ELIST = WS_RTW + al256((size_t)MROWS * 2 * 4);
constexpr size_t WS_BIG = WS_ELIST + al256((size_t)NE * MROWS * 4);
constexpr size_t SZ_Q = al256((size_t)MROWS * QKW * 2), SZ_V = al256((size_t)MROWS * VW * 2), SZ_DD = al256((size_t)MROWS * D * 2);
constexpr size_t SZ_U = al256((size_t)UROWS * DE * 2);
constexpr size_t cmax(size_t a, size_t b) { return a > b ? a : b; }
constexpr size_t SZ_BIG = cmax(cmax(2 * SZ_Q + 2 * SZ_V, 3 * SZ_DD), SZ_U);
constexpr size_t WS_Q = WS_BIG, WS_K = WS_Q + SZ_Q, WS_V = WS_K + SZ_Q, WS_O = WS_V + SZ_V;
constexpr size_t WS_GY = WS_BIG, WS_XR = WS_GY + SZ_DD, WS_XC = WS_XR + SZ_DD;
constexpr size_t WS_U = WS_BIG;
constexpr size_t WS_BIG2 = WS_BIG + SZ_BIG;
constexpr size_t SZ_BIG2 = cmax(al256((size_t)MROWS * RBK * 4), al256((size_t)MROWS * 2 * D * 2));
constexpr size_t WS_HS = WS_BIG2, WS_Y = WS_BIG2;
constexpr size_t WS_END = WS_BIG2 + SZ_BIG2;

constexpr int CW_BAR = 4096;
constexpr int CW_ECNT = 16384;

struct Params {
    const float *x, *c, *ctx, *c_ctx, *w_ada, *b_ada, *g_mix, *g_ffn, *g_final;
    const float *m_w_in, *m_b_gate, *m_g_head, *m_w_out;
    const float *r_w_in, *r_conv_w, *r_conv_b, *r_w_gate, *r_b_gate, *r_lam, *r_w_out;
    const float *w_router, *b_router, *e_w1, *e_w3, *e_w2;
    float* out; unsigned char* ws;
    int ph_lo, ph_hi;
};
#define WSP(T, off) ((T*)(p.ws + (off)))

HD float pos_embed(int t, int k) {
    const int quarter = D / 4; const int rr = t / GRIDW, cc = t % GRIDW;
    const int q = k % quarter, sec = k / quarter;
    const float f = expf(-9.210340371976184f * (float)q / (float)quarter);
    const float pp = (sec < 2) ? (float)rr : (float)cc;
    const float ang = pp * f;
    return (sec & 1) ? cosf(ang) : sinf(ang);
}
HD void route16(const float* lg, const float* b_router, int& e0, int& e1, float& w0, float& w1) {
    float mx = lg[0];
#pragma unroll
    for (int e = 1; e < NE; ++e) mx = lg[e] > mx ? lg[e] : mx;
    float sc[NE]; float sum = 0.f;
#pragma unroll
    for (int e = 0; e < NE; ++e) { sc[e] = expf(lg[e] - mx); sum += sc[e]; }
    const float inv = 1.0f / sum;
    float gsbest = -3.0e38f; int be0 = 0, be1 = 1; float bs0 = 0.f, bs1 = 0.f;
#pragma unroll
    for (int g = 0; g < 4; ++g) {
        float m1 = -3.0e38f, m2 = -3.0e38f, s1 = 0.f, s2 = 0.f; int i1 = 0, i2 = 0;
#pragma unroll
        for (int i = 0; i < 4; ++i) {
            const float s = sc[4 * g + i] * inv, v = s + b_router[4 * g + i];
            if (v > m1) { m2 = m1; i2 = i1; s2 = s1; m1 = v; i1 = 4 * g + i; s1 = s; }
            else if (v > m2) { m2 = v; i2 = 4 * g + i; s2 = s; }
        }
        const float gs = m1 + m2;
        if (gs > gsbest) { gsbest = gs; be0 = i1; be1 = i2; bs0 = s1; bs1 = s2; }
    }
    e0 = be0; e1 = be1;
    const float t = 1.0f / (bs0 + bs1);
    w0 = bs0 * t; w1 = bs1 * t;
}
HD int atomic_inc_int(int* p_) {
#if defined(__HIP_DEVICE_COMPILE__)
    return atomicAdd(p_, 1);
#else
    return (*p_)++;
#endif
}
HD int order_pos(int d, int o) { return d == 0 ? o : (o < CTX ? CTX - 1 - o : S - 1 - (o - CTX)); }
struct U4 { unsigned x, y, z, w; };
HD float dot_bf(const bf16* a, const bf16* b, int K) {
    float s = 0.f;
    for (int k = 0; k < K; k += 8) {
        const U4 va = *(const U4*)(a + k), vb = *(const U4*)(b + k);
        s += u2f(va.x << 16) * u2f(vb.x << 16); s += u2f(va.x & 0xFFFF0000u) * u2f(vb.x & 0xFFFF0000u);
        s += u2f(va.y << 16) * u2f(vb.y << 16); s += u2f(va.y & 0xFFFF0000u) * u2f(vb.y & 0xFFFF0000u);
        s += u2f(va.z << 16) * u2f(vb.z << 16); s += u2f(va.z & 0xFFFF0000u) * u2f(vb.z & 0xFFFF0000u);
        s += u2f(va.w << 16) * u2f(vb.w << 16); s += u2f(va.w & 0xFFFF0000u) * u2f(vb.w & 0xFFFF0000u);
    }
    return s;
}

HD void conv_T_item(bf16* dst, const float* src, int K, int N, size_t idx) { const int n = (int)(idx / K), k = (int)(idx % K); dst[idx] = n < N ? f2bf(src[(size_t)k * N + n]) : (bf16)0; }
HD void n_p0a(const Params& p, size_t gtid, size_t nthr) {
    float* SIL = WSP(float, WS_SIL);
    for (size_t i = gtid; i < (size_t)(NB + 1) * D; i += nthr) { const int bp = (int)(i / D), k = (int)(i % D); SIL[i] = siluf_(bp < NB ? p.c[bp * D + k] : p.c_ctx[k]); }
    for (int j = 0; j < 2; ++j) {
        bf16* winm = WSP(bf16, WS_WINM) + (size_t)j * MPROJ_P * D;
        for (size_t i = gtid; i < (size_t)MPROJ_P * D; i += nthr) conv_T_item(winm, p.m_w_in + (size_t)j * D * MPROJ, D, MPROJ, i);
        bf16* woutm = WSP(bf16, WS_WOUTM) + (size_t)j * D * VW;
        for (size_t i = gtid; i < (size_t)D * VW; i += nthr) conv_T_item(woutm, p.m_w_out + (size_t)j * VW * D, VW, D, i);
        bf16* winr = WSP(bf16, WS_WINR) + (size_t)j * 2 * D * D;
        for (size_t i = gtid; i < (size_t)2 * D * D; i += nthr) conv_T_item(winr, p.r_w_in + (size_t)j * D * 2 * D, D, 2 * D, i);
        bf16* woutr = WSP(bf16, WS_WOUTR) + (size_t)j * D * D;
        for (size_t i = gtid; i < (size_t)D * D; i += nthr) conv_T_item(woutr, p.r_w_out + (size_t)j * D * D, D, D, i);
        for (int dn = 0; dn < 16; ++dn) {
            bf16* wg = WSP(bf16, WS_WG) + ((size_t)j * 16 + dn) * 2 * RBW * RBW;
            for (size_t i = gtid; i < (size_t)2 * RBW * RBW; i += nthr) conv_T_item(wg, p.r_w_gate + ((size_t)j * 16 + dn) * RBW * 2 * RBW, RBW, 2 * RBW, i);
        }
    }
    for (int ie = 0; ie < DEPTH * NE; ++ie) {
        bf16* w13 = WSP(bf16, WS_W13) + (size_t)ie * 2 * DE * D;
        const float* w1 = p.e_w1 + (size_t)ie * D * DE; const float* w3 = p.e_w3 + (size_t)ie * D * DE;
        for (size_t i = gtid; i < (size_t)2 * DE * D; i += nthr) {
            const int rr = (int)(i / D), k = (int)(i % D); const int blk = rr / (2 * G13), w = (rr / G13) & 1, hc = blk * G13 + rr % G13;
            w13[i] = f2bf((w ? w3 : w1)[(size_t)k * DE + hc]);
        }
        bf16* w2 = WSP(bf16, WS_W2) + (size_t)ie * D * DE;
        for (size_t i = gtid; i < (size_t)D * DE; i += nthr) conv_T_item(w2, p.e_w2 + (size_t)ie * DE * D, DE, D, i);
    }
}
HD void n_p0b(const Params& p, size_t gtid, size_t nthr) {
    const float* SIL = WSP(float, WS_SIL); float* MOD = WSP(float, WS_MOD);
    for (size_t it = gtid; it < (size_t)DEPTH * 6 * D; it += nthr) {
        const int i = (int)(it / (6 * D)), n = (int)(it % (6 * D));
        float acc[NB + 1];
        for (int bp = 0; bp <= NB; ++bp) acc[bp] = p.b_ada[i * 6 * D + n];
        const float* w = p.w_ada + (size_t)i * D * 6 * D + n;
        for (int k = 0; k < D; ++k) { const float wv = w[(size_t)k * 6 * D]; for (int bp = 0; bp <= NB; ++bp) acc[bp] += SIL[bp * D + k] * wv; }
        for (int bp = 0; bp <= NB; ++bp) MOD[((size_t)i * (NB + 1) + bp) * 6 * D + n] = acc[bp];
    }
}
HD void n_t1(const Params& p, int i, size_t gtid, size_t nthr) {
    float* X = WSP(float, WS_X); bf16* HB = WSP(bf16, WS_HB); const bf16* Y = WSP(bf16, WS_Y); const float* MOD = WSP(float, WS_MOD);
    for (size_t r = gtid; r < (size_t)MROWS; r += nthr) {
        const int b = (int)(r / S), s = (int)(r % S); const bool isctx = s < CTX; const int bp = isctx ? NB : b;
        if (i == DEPTH && isctx) continue;
        float* xr = X + r * D;
        float ss = 0.f;
        for (int k = 0; k < D; ++k) {
            float v;
            if (i == 0) v = isctx ? p.ctx[((size_t)b * CTX + s) * D + k] : p.x[((size_t)b * SEQ + (s - CTX)) * D + k] + pos_embed(s - CTX, k);
            else { const float g5 = MOD[((size_t)(i - 1) * (NB + 1) + bp) * 6 * D + 5 * D + k]; v = xr[k] + g5 * (bf2f(Y[(r * 2 + 0) * D + k]) + bf2f(Y[(r * 2 + 1) * D + k])); }
            xr[k] = v; ss += v * v;
        }
        const float rstd = 1.0f / sqrtf(ss / (float)D + EPS);
        if (i == DEPTH) { float* o = p.out + ((size_t)b * SEQ + (s - CTX)) * D; for (int k = 0; k < D; ++k) o[k] = xr[k] * rstd * p.g_final[k]; continue; }
        const float* mod = MOD + ((size_t)i * (NB + 1) + bp) * 6 * D;
        for (int k = 0; k < D; ++k) HB[r * D + k] = f2bf(xr[k] * rstd * p.g_mix[i * D + k] * (1.0f + mod[D + k]) + mod[k]);
    }
}
HD void epi_g1m(const Params& p, int j, size_t r, int n, float v) {
    if (n < QKW) WSP(bf16, WS_Q)[r * QKW + n] = f2bf(v * (1.0f / sqrtf((float)DQK)));
    else if (n < 2 * QKW) WSP(bf16, WS_K)[r * QKW + n - QKW] = f2bf(v);
    else if (n < 2 * QKW + VW) WSP(bf16, WS_V)[r * VW + n - 2 * QKW] = f2bf(v);
    else if (n < 2 * QKW + 2 * VW) WSP(bf16, WS_O)[r * VW + n - 2 * QKW - VW] = f2bf(sigmoidf_(v));
    else if (n < MPROJ) { const int g = n - 2 * QKW - 2 * VW, gi = g / NH; v += p.m_b_gate[j * 4 * NH + g]; if (gi & 1) v = logsigmoidf_(v); WSP(float, WS_GT)[r * 4 * NH + g] = v; }
}
HD void epi_g1r(const Params& p, size_t r, int n, float v) {
    if (n < D) WSP(bf16, WS_GY)[r * D + n] = f2bf(geluf_(v)); else WSP(bf16, WS_XR)[r * D + n - D] = f2bf(v);
}
HD void n_g1(const Params& p, int i, size_t gtid, size_t nthr) {
    const bf16* HB = WSP(bf16, WS_HB); const int j = i >> 1;
    if ((i & 1) == 0) {
        const bf16* W = WSP(bf16, WS_WINM) + (size_t)j * MPROJ_P * D;
        for (size_t it = gtid; it < (size_t)MROWS * MPROJ; it += nthr) { const size_t r = it / MPROJ; const int n = (int)(it % MPROJ); epi_g1m(p, j, r, n, dot_bf(HB + r * D, W + (size_t)n * D, D)); }
    } else {
        const bf16* W = WSP(bf16, WS_WINR) + (size_t)j * 2 * D * D;
        for (size_t it = gtid; it < (size_t)MROWS * 2 * D; it += nthr) { const size_t r = it / (2 * D); const int n = (int)(it % (2 * D)); epi_g1r(p, r, n, dot_bf(HB + r * D, W + (size_t)n * D, D)); }
    }
}
HD void n_mlstm_dir(const Params& p, int d, size_t gtid, size_t nthr) {
    const bf16* Q = WSP(bf16, WS_Q); const bf16* Kb = WSP(bf16, WS_K); const bf16* V = WSP(bf16, WS_V); const float* GT = WSP(float, WS_GT); float* HS = WSP(float, WS_HS);
    for (size_t it = gtid; it < (size_t)NB * NH * DV; it += nthr) {
        const int b = (int)(it / (NH * DV)), h = (int)((it / DV) % NH), v = (int)(it % DV);
        float C[DQK], nn[DQK]; float m = 0.f;
#pragma unroll
        for (int k = 0; k < DQK; ++k) { C[k] = 0.f; nn[k] = 0.f; }
        for (int o = 0; o < S; ++o) {
            const size_t r = (size_t)b * S + order_pos(d, o);
            const float ig = GT[r * 4 * NH + (2 * d) * NH + h], lf = GT[r * 4 * NH + (2 * d + 1) * NH + h];
            const float mn = fmaxf(lf + m, ig), fd = expf(lf + m - mn), iw = expf(ig - mn); m = mn;
            const float vv = bf2f(V[r * VW + h * DV + v]);
            float num = 0.f, den = 0.f;
#pragma unroll
            for (int k = 0; k < DQK; ++k) {
                const float kk = bf2f(Kb[r * QKW + h * DQK + k]), qq = bf2f(Q[r * QKW + h * DQK + k]);
                C[k] = fd * C[k] + iw * kk * vv; nn[k] = fd * nn[k] + iw * kk; num += qq * C[k]; den += qq * nn[k];
            }
            const float hv = num / fmaxf(fabsf(den), expf(-m));
            float* dst = HS + r * VW + h * DV + v;
            if (d == 0) *dst = hv; else *dst += hv;
        }
    }
}
HD void n_mlstm_out(const Params& p, int i, size_t gtid, size_t nthr) {
    const float* HS = WSP(float, WS_HS); const bf16* O = WSP(bf16, WS_O); bf16* RB = WSP(bf16, WS_RB); const int j = i >> 1;
    for (size_t it = gtid; it < (size_t)MROWS * NH; it += nthr) {
        const size_t r = it / NH; const int h = (int)(it % NH);
        float ss = 0.f; for (int v = 0; v < DV; ++v) { const float x = HS[r * VW + h * DV + v]; ss += x * x; }
        const float rs = 1.0f / sqrtf(ss / (float)DV + EPS);
        for (int v = 0; v < DV; ++v) { const int c = h * DV + v; RB[r * RBK + c] = f2bf(HS[r * VW + c] * rs * p.m_g_head[j * VW + c] * bf2f(O[r * VW + c])); }
    }
}
HD void n_rg_conv(const Params& p, int i, size_t gtid, size_t nthr) {
    const bf16* XR = WSP(bf16, WS_XR); bf16* XC = WSP(bf16, WS_XC); const int j = i >> 1;
    for (size_t it = gtid; it < (size_t)MROWS * D; it += nthr) {
        const size_t r = it / D; const int ch = (int)(it % D); const int s = (int)(r % S); const int lo = s < CTX ? 0 : CTX, hi = s < CTX ? CTX : S;
        float y = p.r_conv_b[j * D + ch];
        for (int t = 0; t < 4; ++t) { const int ss = s + t - 2; if (ss >= lo && ss < hi) y += p.r_conv_w[(j * 4 + t) * D + ch] * bf2f(XR[(r + t - 2) * D + ch]); }
        XC[it] = f2bf(y);
    }
}
HD void n_rg_dir(const Params& p, int i, int d, size_t gtid, size_t nthr) {
    const bf16* XC = WSP(bf16, WS_XC); float* HS = WSP(float, WS_HS); const int j = i >> 1;
    for (size_t it = gtid; it < (size_t)NB * D; it += nthr) {
        const int b = (int)(it / D), ch = (int)(it % D), n = ch / RBW, jc = ch % RBW;
        const bf16* wg = WSP(bf16, WS_WG) + (((size_t)j * 2 + d) * 8 + n) * 2 * RBW * RBW;
        const float* bg = p.r_b_gate + (((size_t)j * 2 + d) * 8 + n) * 2 * RBW;
        const float sp = softplusf_(-p.r_lam[(j * 2 + d) * D + ch]);
        float h = 0.f;
        for (int o = 0; o < S; ++o) {
            const size_t r = (size_t)b * S + order_pos(d, o);
            const float gr = bg[jc] + dot_bf(XC + r * D + n * RBW, wg + (size_t)jc * RBW, RBW);
            const float gi = bg[RBW + jc] + dot_bf(XC + r * D + n * RBW, wg + (size_t)(RBW + jc) * RBW, RBW);
            const float rr = sigmoidf_(gr), ii = sigmoidf_(gi), la = -8.0f * rr * sp, a = expf(la);
            const float bx = sqrtf(-expm1f(2.0f * la)) * (ii * bf2f(XC[r * D + ch]));
            h = a * h + bx;
            float* dst = HS + r * RBK + ch;
            if (d == 0) *dst = h; else *dst += h;
        }
    }
}
HD void n_rg_out(const Params& p, size_t gtid, size_t nthr) {
    const float* HS = WSP(float, WS_HS); const bf16* GY = WSP(bf16, WS_GY); bf16* RB = WSP(bf16, WS_RB);
    for (size_t it = gtid; it < (size_t)MROWS * D; it += nthr) { const size_t r = it / D; const int ch = (int)(it % D); RB[r * RBK + ch] = f2bf(bf2f(GY[it]) * HS[r * RBK + ch]); }
}
HD void n_g2(const Params& p, int i, size_t gtid, size_t nthr) {
    const bf16* RB = WSP(bf16, WS_RB); bf16* HB = WSP(bf16, WS_HB); const int j = i >> 1; const int K = (i & 1) ? D : VW;
    const bf16* W = (i & 1) ? WSP(bf16, WS_WOUTR) + (size_t)j * D * D : WSP(bf16, WS_WOUTM) + (size_t)j * D * VW;
    for (size_t it = gtid; it < (size_t)MROWS * D; it += nthr) {
        const size_t r = it / D; const int n = (int)(it % D);
        if (i == DEPTH - 1 && (int)(r % S) < CTX) continue;
        HB[it] = f2bf(dot_bf(RB + r * RBK, W + (size_t)n * K, K));
    }
}
HD void n_t2(const Params& p, int i, size_t gtid, size_t nthr) {
    float* X = WSP(float, WS_X); bf16* HB = WSP(bf16, WS_HB); const float* MOD = WSP(float, WS_MOD);
    int* RTE = WSP(int, WS_RTE); float* RTW = WSP(float, WS_RTW); int* EL = WSP(int, WS_ELIST); int* ECNT = WSP(int, WS_CTL) + CW_ECNT + i * NE;
    for (size_t r = gtid; r < (size_t)MROWS; r += nthr) {
        const int b = (int)(r / S), s = (int)(r % S); const bool isctx = s < CTX; const int bp = isctx ? NB : b;
        if (i == DEPTH - 1 && isctx) continue;
        const float* mod = MOD + ((size_t)i * (NB + 1) + bp) * 6 * D;
        float* xr = X + r * D; float ss = 0.f;
        for (int k = 0; k < D; ++k) { const float v = xr[k] + mod[2 * D + k] * bf2f(HB[r * D + k]); xr[k] = v; ss += v * v; }
        const float rstd = 1.0f / sqrtf(ss / (float)D + EPS);
        float lg[NE]; for (int e = 0; e < NE; ++e) lg[e] = 0.f;
        for (int k = 0; k < D; ++k) {
            const float h = xr[k] * rstd * p.g_ffn[i * D + k] * (1.0f + mod[4 * D + k]) + mod[3 * D + k];
            HB[r * D + k] = f2bf(h);
            for (int e = 0; e < NE; ++e) lg[e] += h * p.w_router[k * NE + e];
        }
        int e0, e1; float w0, w1; route16(lg, p.b_router, e0, e1, w0, w1);
        RTE[r * 2] = e0; RTE[r * 2 + 1] = e1; RTW[r * 2] = w0; RTW[r * 2 + 1] = w1;
        const int p0 = atomic_inc_int(ECNT + e0); EL[(size_t)e0 * MROWS + p0] = (int)r * 2;
        const int p1 = atomic_inc_int(ECNT + e1); EL[(size_t)e1 * MROWS + p1] = (int)r * 2 + 1;
    }
}
HD int moe_locate(const Params& p, int i, int tile, int& e_, int& tb_, int& cnt_) {
    const int* ECNT = WSP(int, WS_CTL) + CW_ECNT + i * NE; int acc = 0; e_ = -1; tb_ = 0; cnt_ = 0;
#pragma unroll
    for (int e = 0; e < NE; ++e) { const int c = ECNT[e], nt = (c + 255) / 256; if (tile >= acc && tile < acc + nt) { e_ = e; tb_ = acc; cnt_ = c; } acc += nt; }
    return acc;
}
HD void n_g3(const Params& p, int i, size_t gtid, size_t nthr) {
    int e, tb, cnt; const int ntile = moe_locate(p, i, 0, e, tb, cnt);
    const bf16* HB = WSP(bf16, WS_HB); bf16* U = WSP(bf16, WS_U); const int* EL = WSP(int, WS_ELIST);
    for (size_t it = gtid; it < (size_t)ntile * 256 * DE; it += nthr) {
        const int ur = (int)(it / DE), hc = (int)(it % DE); moe_locate(p, i, ur / 256, e, tb, cnt);
        const int pos = ur - tb * 256; if (pos >= cnt) continue;
        const size_t row = (size_t)(EL[(size_t)e * MROWS + pos] >> 1);
        const bf16* w13 = WSP(bf16, WS_W13) + ((size_t)i * NE + e) * 2 * DE * D;
        const int rr1 = (hc / G13) * 2 * G13 + hc % G13;
        const float a = dot_bf(HB + row * D, w13 + (size_t)rr1 * D, D), bb = dot_bf(HB + row * D, w13 + (size_t)(rr1 + G13) * D, D);
        U[(size_t)ur * DE + hc] = f2bf(siluf_(a) * bb);
    }
}
HD void n_g4(const Params& p, int i, size_t gtid, size_t nthr) {
    int e, tb, cnt; const int ntile = moe_locate(p, i, 0, e, tb, cnt);
    const bf16* U = WSP(bf16, WS_U); bf16* Y = WSP(bf16, WS_Y); const int* EL = WSP(int, WS_ELIST); const float* RTW = WSP(float, WS_RTW);
    for (size_t it = gtid; it < (size_t)ntile * 256 * D; it += nthr) {
        const int ur = (int)(it / D), n = (int)(it % D); moe_locate(p, i, ur / 256, e, tb, cnt);
        const int pos = ur - tb * 256; if (pos >= cnt) continue;
        const int ent = EL[(size_t)e * MROWS + pos];
        const bf16* w2 = WSP(bf16, WS_W2) + ((size_t)i * NE + e) * D * DE;
        Y[(size_t)ent * D + n] = f2bf(RTW[ent] * dot_bf(U + (size_t)ur * DE, w2 + (size_t)n * DE, DE));
    }
}

constexpr int PH_PER_LAYER = 10, N_PHASES = 2 + DEPTH * PH_PER_LAYER + 1;
#ifndef HOST_EMU
__host__ __device__
#endif
inline bool phase_used(int ph) {
    if (ph < 2 || ph >= 2 + DEPTH * PH_PER_LAYER) return true;
    const int i = (ph - 2) / PH_PER_LAYER, k = (ph - 2) % PH_PER_LAYER;
    if ((i & 1) == 0 && k == 5) return false;
    return true;
}
#define RUN_NAIVE(call) do { call; } while (0)
HD void run_phase(const Params& p, int ph, size_t gtid, size_t nthr) {
    if (ph == 0) { n_p0a(p, gtid, nthr); return; }
    if (ph == 1) { n_p0b(p, gtid, nthr); return; }
    if (ph == 2 + DEPTH * PH_PER_LAYER) { n_t1(p, DEPTH, gtid, nthr); return; }
    const int i = (ph - 2) / PH_PER_LAYER, k = (ph - 2) % PH_PER_LAYER; const bool ml = (i & 1) == 0;
    switch (k) {
        case 0: n_t1(p, i, gtid, nthr); break;
        case 1: n_g1(p, i, gtid, nthr); break;
        case 2: if (ml) n_mlstm_dir(p, 0, gtid, nthr); else n_rg_conv(p, i, gtid, nthr); break;
        case 3: if (ml) n_mlstm_dir(p, 1, gtid, nthr); else n_rg_dir(p, i, 0, gtid, nthr); break;
        case 4: if (ml) n_mlstm_out(p, i, gtid, nthr); else n_rg_dir(p, i, 1, gtid, nthr); break;
        case 5: if (!ml) n_rg_out(p, gtid, nthr); break;
        case 6: n_g2(p, i, gtid, nthr); break;
        case 7: n_t2(p, i, gtid, nthr); break;
        case 8: n_g3(p, i, gtid, nthr); break;
        case 9: n_g4(p, i, gtid, nthr); break;
    }
}

#ifndef HOST_EMU
template <int K> __global__ void __launch_bounds__(256) k_naive(Params p, int i) {
    const size_t gtid = (size_t)blockIdx.x * blockDim.x + threadIdx.x, nthr = (size_t)gridDim.x * blockDim.x;
    if constexpr (K == 0) n_p0a(p, gtid, nthr);
    if constexpr (K == 1) n_p0b(p, gtid, nthr);
    if constexpr (K == 2) n_t1(p, i, gtid, nthr);
    if constexpr (K == 3) n_g1(p, i, gtid, nthr);
    if constexpr (K == 4) n_mlstm_dir(p, 0, gtid, nthr);
    if constexpr (K == 5) n_mlstm_dir(p, 1, gtid, nthr);
    if constexpr (K == 6) n_mlstm_out(p, i, gtid, nthr);
    if constexpr (K == 7) n_rg_conv(p, i, gtid, nthr);
    if constexpr (K == 8) n_rg_dir(p, i, 0, gtid, nthr);
    if constexpr (K == 9) n_rg_dir(p, i, 1, gtid, nthr);
    if constexpr (K == 10) n_rg_out(p, gtid, nthr);
    if constexpr (K == 11) n_g2(p, i, gtid, nthr);
    if constexpr (K == 12) n_t2(p, i, gtid, nthr);
    if constexpr (K == 13) n_g3(p, i, gtid, nthr);
    if constexpr (K == 14) n_g4(p, i, gtid, nthr);
}
#define LN(K, blocks, layer) hipLaunchKernelGGL(k_naive<K>, dim3(blocks), dim3(256), 0, stream, p, layer)

extern "C" void kernel_launch(void* const* d_in, const int* in_sizes, int n_in, void* d_out, int out_size, void* d_ws, size_t ws_size, hipStream_t stream) {
    if (n_in != 25 || in_sizes[0] != NB * SEQ * D || out_size != NB * SEQ * D || ws_size < WS_END) {
        fprintf(stderr, "kernel_launch: unexpected shapes / workspace (n_in %d, in0 %d, out %d, ws %zu < %zu): nothing launched\n", n_in, n_in > 0 ? in_sizes[0] : -1, out_size, ws_size, (size_t)WS_END);
        return;
    }
    (void)hipMemsetAsync((char*)d_ws + WS_CTL, 0, CTL_BYTES, stream);
    Params p{};
    const float** f = (const float**)&p;
    for (int i = 0; i < 25; ++i) f[i] = (const float*)d_in[i];
    p.out = (float*)d_out; p.ws = (unsigned char*)d_ws;
    LN(0, 2048, 0); LN(1, 96, 0);
    for (int i = 0; i < DEPTH; ++i) {
        LN(2, 72, i); LN(3, 4096, i);
        if ((i & 1) == 0) { LN(4, 64, i); LN(5, 64, i); LN(6, 576, i); }
        else { LN(7, 2048, i); LN(8, 32, i); LN(9, 32, i); LN(10, 2048, i); }
        LN(11, 4096, i); LN(12, 72, i); LN(13, 4096, i); LN(14, 4096, i);
    }
    LN(2, 72, DEPTH);
}
#endif
```

```cpp
#ifndef HOST_EMU
#include <hip/hip_runtime.h>
#include <cstdio>
#include <cstdint>
#define HD __device__ __forceinline__
#define DEV __device__ __forceinline__
#else
#include <cmath>
#include <cstdio>
#include <cstdint>
#include <cstring>
#define HD inline
#define DEV inline
#endif

#ifndef CFG_D
#define CFG_D 1024
#define CFG_B 8
#define CFG_SEQ 2048
#define CFG_CTX 256
#define CFG_DQK 64
#define CFG_DV 128
#define CFG_DE 512
#endif
constexpr int D = CFG_D, NB = CFG_B, SEQ = CFG_SEQ, CTX = CFG_CTX, DEPTH = 4, NH = 8, DQK = CFG_DQK, DV = CFG_DV, NE = 16, DE = CFG_DE;
constexpr int S = CTX + SEQ;
constexpr int MROWS = NB * S;
constexpr int QKW = NH * DQK, VW = NH * DV, MPROJ = 2 * QKW + 2 * VW + 4 * NH;
constexpr int MPROJ_P = (MPROJ + 255) / 256 * 256;
constexpr int RBW = D / 8;
constexpr int G13 = DE < 128 ? DE : 128;
constexpr int GRIDW = 64;
constexpr float EPS = 1e-6f;
constexpr int UROWS = 2 * MROWS + NE * 256;

typedef unsigned short bf16;
HD unsigned f2u(float f) { unsigned u; memcpy(&u, &f, 4); return u; }
HD float u2f(unsigned u) { float f; memcpy(&f, &u, 4); return f; }
HD bf16 f2bf(float f) { unsigned u = f2u(f); u += 0x7FFFu + ((u >> 16) & 1u); return (bf16)(u >> 16); }
HD float bf2f(bf16 b) { return u2f(((unsigned)b) << 16); }
HD float sigmoidf_(float x) { return 1.0f / (1.0f + expf(-x)); }
HD float siluf_(float x) { return x / (1.0f + expf(-x)); }
HD float logsigmoidf_(float x) { return x >= 0.f ? -log1pf(expf(-x)) : x - log1pf(expf(x)); }
HD float softplusf_(float x) { return x > 0.f ? x + log1pf(expf(-x)) : log1pf(expf(x)); }
HD float geluf_(float x) { return 0.5f * x * (1.0f + tanhf(0.7978845608028654f * (x + 0.044715f * x * x * x))); }

constexpr size_t al256(size_t x) { return (x + 255) / 256 * 256; }
constexpr size_t WS_CTL = 0, CTL_BYTES = 1u << 20;
constexpr size_t WS_MOD = WS_CTL + CTL_BYTES;
constexpr size_t WS_SIL = WS_MOD + al256((size_t)DEPTH * (NB + 1) * 6 * D * 4);
constexpr size_t WS_WINM = WS_SIL + al256((size_t)(NB + 1) * D * 4);
constexpr size_t WS_WOUTM = WS_WINM + al256((size_t)2 * MPROJ_P * D * 2);
constexpr size_t WS_WINR = WS_WOUTM + al256((size_t)2 * D * VW * 2);
constexpr size_t WS_WOUTR = WS_WINR + al256((size_t)2 * 2 * D * D * 2);
constexpr size_t WS_WG = WS_WOUTR + al256((size_t)2 * D * D * 2);
constexpr size_t WS_W13 = WS_WG + al256((size_t)2 * 2 * 8 * 2 * RBW * RBW * 2);
constexpr size_t WS_W2 = WS_W13 + al256((size_t)DEPTH * NE * 2 * DE * D * 2);
constexpr size_t WS_X = WS_W2 + al256((size_t)DEPTH * NE * D * DE * 2);
constexpr size_t SKEW = 0x11100;
constexpr size_t WS_HB = WS_X + al256((size_t)MROWS * D * 4) + SKEW;
constexpr size_t WS_RB = WS_HB + al256((size_t)MROWS * D * 2) + SKEW;
constexpr int RBK = VW > D ? VW : D;
constexpr size_t WS_GT = WS_RB + al256((size_t)MROWS * RBK * 2) + SKEW;
constexpr size_t WS_RTE = WS_GT + al256((size_t)MROWS * 4 * NH * 4);
constexpr size_t WS_RTW = WS_RTE + al256((size_t)MROWS * 2 * 4);
constexpr size_t WS_ELIST = WS_RTW + al256((size_t)MROWS * 2 * 4);
constexpr int NCH = S / 64;
constexpr size_t WS_ND = WS_ELIST + al256((size_t)NE * MROWS * 8);
constexpr size_t WS_SC = WS_ND + al256((size_t)2 * NB * NH * NCH * DQK * 4);
constexpr size_t WS_MS = WS_SC + al256((size_t)2 * NB * NH * NCH * 2 * 4);
constexpr size_t WS_RSUM = WS_MS + al256((size_t)2 * NB * NH * NCH * 4);
constexpr size_t WS_RCIN = WS_RSUM + al256((size_t)2 * NB * NCH * D * 2 * 4);
constexpr size_t WS_BIG = WS_RCIN + al256((size_t)2 * NB * NCH * D * 4);
constexpr size_t SZ_Q = al256((size_t)MROWS * QKW * 2) + SKEW, SZ_V = al256((size_t)MROWS * VW * 2) + SKEW, SZ_DD = al256((size_t)MROWS * D * 2) + SKEW;
constexpr size_t SZ_U = al256((size_t)UROWS * DE * 2);
constexpr size_t cmax(size_t a, size_t b) { return a > b ? a : b; }
constexpr size_t SZ_BIG = cmax(cmax(2 * SZ_Q + 2 * SZ_V, 3 * SZ_DD), SZ_U);
constexpr size_t WS_Q = WS_BIG, WS_K = WS_Q + SZ_Q, WS_V = WS_K + SZ_Q, WS_O = WS_V + SZ_V;
constexpr size_t WS_GY = WS_BIG, WS_XR = WS_GY + SZ_DD, WS_XC = WS_XR + SZ_DD;
constexpr size_t WS_U = WS_BIG;
constexpr size_t WS_BIG2 = WS_BIG + SZ_BIG + SKEW;
constexpr size_t SZ_BIG2 = cmax(al256((size_t)MROWS * RBK * 4), al256((size_t)MROWS * 2 * D * 2)) + SKEW;
constexpr size_t WS_HS = WS_BIG2, WS_Y = WS_BIG2;
constexpr size_t WS_END = WS_BIG2 + SZ_BIG2;

constexpr int CW_BAR = 4096;
constexpr int CW_ECNT = 16384;

struct Params {
    const float *x, *c, *ctx, *c_ctx, *w_ada, *b_ada, *g_mix, *g_ffn, *g_final;
    const float *m_w_in, *m_b_gate, *m_g_head, *m_w_out;
    const float *r_w_in, *r_conv_w, *r_conv_b, *r_w_gate, *r_b_gate, *r_lam, *r_w_out;
    const float *w_router, *b_router, *e_w1, *e_w3, *e_w2;
    float* out; unsigned char* ws;
    int ph_lo, ph_hi;
};
#define WSP(T, off) ((T*)(p.ws + (off)))

HD float pos_embed(int t, int k) {
    const int quarter = D / 4; const int rr = t / GRIDW, cc = t % GRIDW;
    const int q = k % quarter, sec = k / quarter;
    const float f = expf(-9.210340371976184f * (float)q / (float)quarter);
    const float pp = (sec < 2) ? (float)rr : (float)cc;
    const float ang = pp * f;
    return (sec & 1) ? cosf(ang) : sinf(ang);
}
HD void route16(const float* lg, const float* b_router, int& e0, int& e1, float& w0, float& w1) {
    float mx = lg[0];
#pragma unroll
    for (int e = 1; e < NE; ++e) mx = lg[e] > mx ? lg[e] : mx;
    float sc[NE]; float sum = 0.f;
#pragma unroll
    for (int e = 0; e < NE; ++e) { sc[e] = expf(lg[e] - mx); sum += sc[e]; }
    const float inv = 1.0f / sum;
    float gsbest = -3.0e38f; int be0 = 0, be1 = 1; float bs0 = 0.f, bs1 = 0.f;
#pragma unroll
    for (int g = 0; g < 4; ++g) {
        float m1 = -3.0e38f, m2 = -3.0e38f, s1 = 0.f, s2 = 0.f; int i1 = 0, i2 = 0;
#pragma unroll
        for (int i = 0; i < 4; ++i) {
            const float s = sc[4 * g + i] * inv, v = s + b_router[4 * g + i];
            if (v > m1) { m2 = m1; i2 = i1; s2 = s1; m1 = v; i1 = 4 * g + i; s1 = s; }
            else if (v > m2) { m2 = v; i2 = 4 * g + i; s2 = s; }
        }
        const float gs = m1 + m2;
        if (gs > gsbest) { gsbest = gs; be0 = i1; be1 = i2; bs0 = s1; bs1 = s2; }
    }
    e0 = be0; e1 = be1;
    const float t = 1.0f / (bs0 + bs1);
    w0 = bs0 * t; w1 = bs1 * t;
}
HD int atomic_inc_int(int* p_) {
#if defined(__HIP_DEVICE_COMPILE__)
    return atomicAdd(p_, 1);
#else
    return (*p_)++;
#endif
}
HD int order_pos(int d, int o) { return d == 0 ? o : (o < CTX ? CTX - 1 - o : S - 1 - (o - CTX)); }
struct U4 { unsigned x, y, z, w; };
HD float dot_bf(const bf16* a, const bf16* b, int K) {
    float s = 0.f;
    for (int k = 0; k < K; k += 8) {
        const U4 va = *(const U4*)(a + k), vb = *(const U4*)(b + k);
        s += u2f(va.x << 16) * u2f(vb.x << 16); s += u2f(va.x & 0xFFFF0000u) * u2f(vb.x & 0xFFFF0000u);
        s += u2f(va.y << 16) * u2f(vb.y << 16); s += u2f(va.y & 0xFFFF0000u) * u2f(vb.y & 0xFFFF0000u);
        s += u2f(va.z << 16) * u2f(vb.z << 16); s += u2f(va.z & 0xFFFF0000u) * u2f(vb.z & 0xFFFF0000u);
        s += u2f(va.w << 16) * u2f(vb.w << 16); s += u2f(va.w & 0xFFFF0000u) * u2f(vb.w & 0xFFFF0000u);
    }
    return s;
}

HD void conv_T_item(bf16* dst, const float* src, int K, int N, size_t idx) { const int n = (int)(idx / K), k = (int)(idx % K); dst[idx] = n < N ? f2bf(src[(size_t)k * N + n]) : (bf16)0; }
HD void n_p0a(const Params& p, size_t gtid, size_t nthr) {
    float* SIL = WSP(float, WS_SIL);
    for (size_t i = gtid; i < (size_t)(NB + 1) * D; i += nthr) { const int bp = (int)(i / D), k = (int)(i % D); SIL[i] = siluf_(bp < NB ? p.c[bp * D + k] : p.c_ctx[k]); }
    for (int j = 0; j < 2; ++j) {
        bf16* winm = WSP(bf16, WS_WINM) + (size_t)j * MPROJ_P * D;
        for (size_t i = gtid; i < (size_t)MPROJ_P * D; i += nthr) conv_T_item(winm, p.m_w_in + (size_t)j * D * MPROJ, D, MPROJ, i);
        bf16* woutm = WSP(bf16, WS_WOUTM) + (size_t)j * D * VW;
        for (size_t i = gtid; i < (size_t)D * VW; i += nthr) conv_T_item(woutm, p.m_w_out + (size_t)j * VW * D, VW, D, i);
        bf16* winr = WSP(bf16, WS_WINR) + (size_t)j * 2 * D * D;
        for (size_t i = gtid; i < (size_t)2 * D * D; i += nthr) conv_T_item(winr, p.r_w_in + (size_t)j * D * 2 * D, D, 2 * D, i);
        bf16* woutr = WSP(bf16, WS_WOUTR) + (size_t)j * D * D;
        for (size_t i = gtid; i < (size_t)D * D; i += nthr) conv_T_item(woutr, p.r_w_out + (size_t)j * D * D, D, D, i);
        for (int dn = 0; dn < 16; ++dn) {
            bf16* wg = WSP(bf16, WS_WG) + ((size_t)j * 16 + dn) * 2 * RBW * RBW;
            for (size_t i = gtid; i < (size_t)2 * RBW * RBW; i += nthr) conv_T_item(wg, p.r_w_gate + ((size_t)j * 16 + dn) * RBW * 2 * RBW, RBW, 2 * RBW, i);
        }
    }
    for (int ie = 0; ie < DEPTH * NE; ++ie) {
        bf16* w13 = WSP(bf16, WS_W13) + (size_t)ie * 2 * DE * D;
        const float* w1 = p.e_w1 + (size_t)ie * D * DE; const float* w3 = p.e_w3 + (size_t)ie * D * DE;
        for (size_t i = gtid; i < (size_t)2 * DE * D; i += nthr) {
            const int rr = (int)(i / D), k = (int)(i % D); const int blk = rr / (2 * G13), w = (rr / G13) & 1, hc = blk * G13 + rr % G13;
            w13[i] = f2bf((w ? w3 : w1)[(size_t)k * DE + hc]);
        }
        bf16* w2 = WSP(bf16, WS_W2) + (size_t)ie * D * DE;
        for (size_t i = gtid; i < (size_t)D * DE; i += nthr) conv_T_item(w2, p.e_w2 + (size_t)ie * DE * D, DE, D, i);
    }
}
HD void n_p0b(const Params& p, size_t gtid, size_t nthr) {
    const float* SIL = WSP(float, WS_SIL); float* MOD = WSP(float, WS_MOD);
    for (size_t it = gtid; it < (size_t)DEPTH * 6 * D; it += nthr) {
        const int i = (int)(it / (6 * D)), n = (int)(it % (6 * D));
        float acc[NB + 1];
        for (int bp = 0; bp <= NB; ++bp) acc[bp] = p.b_ada[i * 6 * D + n];
        const float* w = p.w_ada + (size_t)i * D * 6 * D + n;
        for (int k = 0; k < D; ++k) { const float wv = w[(size_t)k * 6 * D]; for (int bp = 0; bp <= NB; ++bp) acc[bp] += SIL[bp * D + k] * wv; }
        for (int bp = 0; bp <= NB; ++bp) MOD[((size_t)i * (NB + 1) + bp) * 6 * D + n] = acc[bp];
    }
}
HD void n_t1(const Params& p, int i, size_t gtid, size_t nthr) {
    float* X = WSP(float, WS_X); bf16* HB = WSP(bf16, WS_HB); const bf16* Y = WSP(bf16, WS_Y); const float* MOD = WSP(float, WS_MOD);
    for (size_t r = gtid; r < (size_t)MROWS; r += nthr) {
        const int b = (int)(r / S), s = (int)(r % S); const bool isctx = s < CTX; const int bp = isctx ? NB : b;
        if (i == DEPTH && isctx) continue;
        float* xr = X + r * D;
        float ss = 0.f;
        for (int k = 0; k < D; ++k) {
            float v;
            if (i == 0) v = isctx ? p.ctx[((size_t)b * CTX + s) * D + k] : p.x[((size_t)b * SEQ + (s - CTX)) * D + k] + pos_embed(s - CTX, k);
            else { const float g5 = MOD[((size_t)(i - 1) * (NB + 1) + bp) * 6 * D + 5 * D + k]; v = xr[k] + g5 * (bf2f(Y[(r * 2 + 0) * D + k]) + bf2f(Y[(r * 2 + 1) * D + k])); }
            xr[k] = v; ss += v * v;
        }
        const float rstd = 1.0f / sqrtf(ss / (float)D + EPS);
        if (i == DEPTH) { float* o = p.out + ((size_t)b * SEQ + (s - CTX)) * D; for (int k = 0; k < D; ++k) o[k] = xr[k] * rstd * p.g_final[k]; continue; }
        const float* mod = MOD + ((size_t)i * (NB + 1) + bp) * 6 * D;
        for (int k = 0; k < D; ++k) HB[r * D + k] = f2bf(xr[k] * rstd * p.g_mix[i * D + k] * (1.0f + mod[D + k]) + mod[k]);
    }
}
HD void epi_g1m(const Params& p, int j, size_t r, int n, float v) {
    if (n < QKW) WSP(bf16, WS_Q)[r * QKW + n] = f2bf(v * (1.0f / sqrtf((float)DQK)));
    else if (n < 2 * QKW) WSP(bf16, WS_K)[r * QKW + n - QKW] = f2bf(v);
    else if (n < 2 * QKW + VW) WSP(bf16, WS_V)[r * VW + n - 2 * QKW] = f2bf(v);
    else if (n < 2 * QKW + 2 * VW) WSP(bf16, WS_O)[r * VW + n - 2 * QKW - VW] = f2bf(sigmoidf_(v));
    else if (n < MPROJ) { const int g = n - 2 * QKW - 2 * VW, gi = g / NH; v += p.m_b_gate[j * 4 * NH + g]; if (gi & 1) v = logsigmoidf_(v); WSP(float, WS_GT)[r * 4 * NH + g] = v; }
}
HD void epi_g1r(const Params& p, size_t r, int n, float v) {
    if (n < D) WSP(bf16, WS_GY)[r * D + n] = f2bf(geluf_(v)); else WSP(bf16, WS_XR)[r * D + n - D] = f2bf(v);
}
HD void n_g1(const Params& p, int i, size_t gtid, size_t nthr) {
    const bf16* HB = WSP(bf16, WS_HB); const int j = i >> 1;
    if ((i & 1) == 0) {
        const bf16* W = WSP(bf16, WS_WINM) + (size_t)j * MPROJ_P * D;
        for (size_t it = gtid; it < (size_t)MROWS * MPROJ; it += nthr) { const size_t r = it / MPROJ; const int n = (int)(it % MPROJ); epi_g1m(p, j, r, n, dot_bf(HB + r * D, W + (size_t)n * D, D)); }
    } else {
        const bf16* W = WSP(bf16, WS_WINR) + (size_t)j * 2 * D * D;
        for (size_t it = gtid; it < (size_t)MROWS * 2 * D; it += nthr) { const size_t r = it / (2 * D); const int n = (int)(it % (2 * D)); epi_g1r(p, r, n, dot_bf(HB + r * D, W + (size_t)n * D, D)); }
    }
}
HD void n_mlstm_dir(const Params& p, int d, size_t gtid, size_t nthr) {
    const bf16* Q = WSP(bf16, WS_Q); const bf16* Kb = WSP(bf16, WS_K); const bf16* V = WSP(bf16, WS_V); const float* GT = WSP(float, WS_GT); float* HS = WSP(float, WS_HS);
    for (size_t it = gtid; it < (size_t)NB * NH * DV; it += nthr) {
        const int b = (int)(it / (NH * DV)), h = (int)((it / DV) % NH), v = (int)(it % DV);
        float C[DQK], nn[DQK]; float m = 0.f;
#pragma unroll
        for (int k = 0; k < DQK; ++k) { C[k] = 0.f; nn[k] = 0.f; }
        for (int o = 0; o < S; ++o) {
            const size_t r = (size_t)b * S + order_pos(d, o);
            const float ig = GT[r * 4 * NH + (2 * d) * NH + h], lf = GT[r * 4 * NH + (2 * d + 1) * NH + h];
            const float mn = fmaxf(lf + m, ig), fd = expf(lf + m - mn), iw = expf(ig - mn); m = mn;
            const float vv = bf2f(V[r * VW + h * DV + v]);
            float num = 0.f, den = 0.f;
#pragma unroll
            for (int k = 0; k < DQK; ++k) {
                const float kk = bf2f(Kb[r * QKW + h * DQK + k]), qq = bf2f(Q[r * QKW + h * DQK + k]);
                C[k] = fd * C[k] + iw * kk * vv; nn[k] = fd * nn[k] + iw * kk; num += qq * C[k]; den += qq * nn[k];
            }
            const float hv = num / fmaxf(fabsf(den), expf(-m));
            float* dst = HS + r * VW + h * DV + v;
            if (d == 0) *dst = hv; else *dst += hv;
        }
    }
}
HD void n_mlstm_out(const Params& p, int i, size_t gtid, size_t nthr) {
    const float* HS = WSP(float, WS_HS); const bf16* O = WSP(bf16, WS_O); bf16* RB = WSP(bf16, WS_RB); const int j = i >> 1;
    for (size_t it = gtid; it < (size_t)MROWS * NH; it += nthr) {
        const size_t r = it / NH; const int h = (int)(it % NH);
        float ss = 0.f; for (int v = 0; v < DV; ++v) { const float x = HS[r * VW + h * DV + v]; ss += x * x; }
        const float rs = 1.0f / sqrtf(ss / (float)DV + EPS);
        for (int v = 0; v < DV; ++v) { const int c = h * DV + v; RB[r * RBK + c] = f2bf(HS[r * VW + c] * rs * p.m_g_head[j * VW + c] * bf2f(O[r * VW + c])); }
    }
}
HD void n_rg_conv(const Params& p, int i, size_t gtid, size_t nthr) {
    const bf16* XR = WSP(bf16, WS_XR); bf16* XC = WSP(bf16, WS_XC); const int j = i >> 1;
    for (size_t it = gtid; it < (size_t)MROWS * D; it += nthr) {
        const size_t r = it / D; const int ch = (int)(it % D); const int s = (int)(r % S); const int lo = s < CTX ? 0 : CTX, hi = s < CTX ? CTX : S;
        float y = p.r_conv_b[j * D + ch];
        for (int t = 0; t < 4; ++t) { const int ss = s + t - 2; if (ss >= lo && ss < hi) y += p.r_conv_w[(j * 4 + t) * D + ch] * bf2f(XR[(r + t - 2) * D + ch]); }
        XC[it] = f2bf(y);
    }
}
HD void n_rg_dir(const Params& p, int i, int d, size_t gtid, size_t nthr) {
    const bf16* XC = WSP(bf16, WS_XC); float* HS = WSP(float, WS_HS); const int j = i >> 1;
    for (size_t it = gtid; it < (size_t)NB * D; it += nthr) {
        const int b = (int)(it / D), ch = (int)(it % D), n = ch / RBW, jc = ch % RBW;
        const bf16* wg = WSP(bf16, WS_WG) + (((size_t)j * 2 + d) * 8 + n) * 2 * RBW * RBW;
        const float* bg = p.r_b_gate + (((size_t)j * 2 + d) * 8 + n) * 2 * RBW;
        const float sp = softplusf_(-p.r_lam[(j * 2 + d) * D + ch]);
        float h = 0.f;
        for (int o = 0; o < S; ++o) {
            const size_t r = (size_t)b * S + order_pos(d, o);
            const float gr = bg[jc] + dot_bf(XC + r * D + n * RBW, wg + (size_t)jc * RBW, RBW);
            const float gi = bg[RBW + jc] + dot_bf(XC + r * D + n * RBW, wg + (size_t)(RBW + jc) * RBW, RBW);
            const float rr = sigmoidf_(gr), ii = sigmoidf_(gi), la = -8.0f * rr * sp, a = expf(la);
            const float bx = sqrtf(-expm1f(2.0f * la)) * (ii * bf2f(XC[r * D + ch]));
            h = a * h + bx;
            float* dst = HS + r * RBK + ch;
            if (d == 0) *dst = h; else *dst += h;
        }
    }
}
HD void n_rg_out(const Params& p, size_t gtid, size_t nthr) {
    const float* HS = WSP(float, WS_HS); const bf16* GY = WSP(bf16, WS_GY); bf16* RB = WSP(bf16, WS_RB);
    for (size_t it = gtid; it < (size_t)MROWS * D; it += nthr) { const size_t r = it / D; const int ch = (int)(it % D); RB[r * RBK + ch] = f2bf(bf2f(GY[it]) * HS[r * RBK + ch]); }
}
HD void n_g2(const Params& p, int i, size_t gtid, size_t nthr) {
    const bf16* RB = WSP(bf16, WS_RB); bf16* HB = WSP(bf16, WS_HB); const int j = i >> 1; const int K = (i & 1) ? D : VW;
    const bf16* W = (i & 1) ? WSP(bf16, WS_WOUTR) + (size_t)j * D * D : WSP(bf16, WS_WOUTM) + (size_t)j * D * VW;
    for (size_t it = gtid; it < (size_t)MROWS * D; it += nthr) {
        const size_t r = it / D; const int n = (int)(it % D);
        if (i == DEPTH - 1 && (int)(r % S) < CTX) continue;
        HB[it] = f2bf(dot_bf(RB + r * RBK, W + (size_t)n * K, K));
    }
}
HD void n_t2(const Params& p, int i, size_t gtid, size_t nthr) {
    float* X = WSP(float, WS_X); bf16* HB = WSP(bf16, WS_HB); const float* MOD = WSP(float, WS_MOD);
    int* RTE = WSP(int, WS_RTE); float* RTW = WSP(float, WS_RTW); int* EL = WSP(int, WS_ELIST); int* ECNT = WSP(int, WS_CTL) + CW_ECNT + i * NE;
    for (size_t r = gtid; r < (size_t)MROWS; r += nthr) {
        const int b = (int)(r / S), s = (int)(r % S); const bool isctx = s < CTX; const int bp = isctx ? NB : b;
        if (i == DEPTH - 1 && isctx) continue;
        const float* mod = MOD + ((size_t)i * (NB + 1) + bp) * 6 * D;
        float* xr = X + r * D; float ss = 0.f;
        for (int k = 0; k < D; ++k) { const float v = xr[k] + mod[2 * D + k] * bf2f(HB[r * D + k]); xr[k] = v; ss += v * v; }
        const float rstd = 1.0f / sqrtf(ss / (float)D + EPS);
        float lg[NE]; for (int e = 0; e < NE; ++e) lg[e] = 0.f;
        for (int k = 0; k < D; ++k) {
            const float h = xr[k] * rstd * p.g_ffn[i * D + k] * (1.0f + mod[4 * D + k]) + mod[3 * D + k];
            HB[r * D + k] = f2bf(h);
            for (int e = 0; e < NE; ++e) lg[e] += h * p.w_router[k * NE + e];
        }
        int e0, e1; float w0, w1; route16(lg, p.b_router, e0, e1, w0, w1);
        RTE[r * 2] = e0; RTE[r * 2 + 1] = e1; RTW[r * 2] = w0; RTW[r * 2 + 1] = w1;
        const int p0 = atomic_inc_int(ECNT + e0); EL[(size_t)e0 * MROWS + p0] = (int)r * 2;
        const int p1 = atomic_inc_int(ECNT + e1); EL[(size_t)e1 * MROWS + p1] = (int)r * 2 + 1;
    }
}
HD int moe_locate(const Params& p, int i, int tile, int& e_, int& tb_, int& cnt_) {
    const int* ECNT = WSP(int, WS_CTL) + CW_ECNT + i * NE; int acc = 0; e_ = -1; tb_ = 0; cnt_ = 0;
#pragma unroll
    for (int e = 0; e < NE; ++e) { const int c = ECNT[e], nt = (c + 255) / 256; if (tile >= acc && tile < acc + nt) { e_ = e; tb_ = acc; cnt_ = c; } acc += nt; }
    return acc;
}
HD void n_g3(const Params& p, int i, size_t gtid, size_t nthr) {
    int e, tb, cnt; const int ntile = moe_locate(p, i, 0, e, tb, cnt);
    const bf16* HB = WSP(bf16, WS_HB); bf16* U = WSP(bf16, WS_U); const int* EL = WSP(int, WS_ELIST);
    for (size_t it = gtid; it < (size_t)ntile * 256 * DE; it += nthr) {
        const int ur = (int)(it / DE), hc = (int)(it % DE); moe_locate(p, i, ur / 256, e, tb, cnt);
        const int pos = ur - tb * 256; if (pos >= cnt) continue;
        const size_t row = (size_t)(EL[(size_t)e * MROWS + pos] >> 1);
        const bf16* w13 = WSP(bf16, WS_W13) + ((size_t)i * NE + e) * 2 * DE * D;
        const int rr1 = (hc / G13) * 2 * G13 + hc % G13;
        const float a = dot_bf(HB + row * D, w13 + (size_t)rr1 * D, D), bb = dot_bf(HB + row * D, w13 + (size_t)(rr1 + G13) * D, D);
        U[(size_t)ur * DE + hc] = f2bf(siluf_(a) * bb);
    }
}
HD void n_g4(const Params& p, int i, size_t gtid, size_t nthr) {
    int e, tb, cnt; const int ntile = moe_locate(p, i, 0, e, tb, cnt);
    const bf16* U = WSP(bf16, WS_U); bf16* Y = WSP(bf16, WS_Y); const int* EL = WSP(int, WS_ELIST); const float* RTW = WSP(float, WS_RTW);
    for (size_t it = gtid; it < (size_t)ntile * 256 * D; it += nthr) {
        const int ur = (int)(it / D), n = (int)(it % D); moe_locate(p, i, ur / 256, e, tb, cnt);
        const int pos = ur - tb * 256; if (pos >= cnt) continue;
        const int ent = EL[(size_t)e * MROWS + pos];
        const bf16* w2 = WSP(bf16, WS_W2) + ((size_t)i * NE + e) * D * DE;
        Y[(size_t)ent * D + n] = f2bf(RTW[ent] * dot_bf(U + (size_t)ur * DE, w2 + (size_t)n * DE, DE));
    }
}

constexpr int PH_PER_LAYER = 10, N_PHASES = 2 + DEPTH * PH_PER_LAYER + 1;
#ifndef HOST_EMU
__host__ __device__
#endif
inline bool phase_used(int ph) {
    if (ph < 2 || ph >= 2 + DEPTH * PH_PER_LAYER) return true;
    const int i = (ph - 2) / PH_PER_LAYER, k = (ph - 2) % PH_PER_LAYER;
    if ((i & 1) == 0 && k == 5) return false;
    return true;
}
#define RUN_NAIVE(call) do { call; } while (0)
HD void run_phase(const Params& p, int ph, size_t gtid, size_t nthr) {
    if (ph == 0) { n_p0a(p, gtid, nthr); return; }
    if (ph == 1) { n_p0b(p, gtid, nthr); return; }
    if (ph == 2 + DEPTH * PH_PER_LAYER) { n_t1(p, DEPTH, gtid, nthr); return; }
    const int i = (ph - 2) / PH_PER_LAYER, k = (ph - 2) % PH_PER_LAYER; const bool ml = (i & 1) == 0;
    switch (k) {
        case 0: n_t1(p, i, gtid, nthr); break;
        case 1: n_g1(p, i, gtid, nthr); break;
        case 2: if (ml) n_mlstm_dir(p, 0, gtid, nthr); else n_rg_conv(p, i, gtid, nthr); break;
        case 3: if (ml) n_mlstm_dir(p, 1, gtid, nthr); else n_rg_dir(p, i, 0, gtid, nthr); break;
        case 4: if (ml) n_mlstm_out(p, i, gtid, nthr); else n_rg_dir(p, i, 1, gtid, nthr); break;
        case 5: if (!ml) n_rg_out(p, gtid, nthr); break;
        case 6: n_g2(p, i, gtid, nthr); break;
        case 7: n_t2(p, i, gtid, nthr); break;
        case 8: n_g3(p, i, gtid, nthr); break;
        case 9: n_g4(p, i, gtid, nthr); break;
    }
}

#ifndef HOST_EMU
#define XB_TMO      128
#define XB_XCNT(j)  (256  + 64 * (j))
#define XB_XSUB(j)  (1280 + 64 * (j))
#define XB_XGEN(j)  (2304 + 64 * (j))
#define XB_TOP      3328
#define XB_TOPGEN   3392
#define XCD_BAR_WORDS 3456
#define XB_SPIN_CAP (1u << 18)
#define LAS __attribute__((address_space(3)))

__device__ __forceinline__ unsigned xb_ld(unsigned* p)              { return __hip_atomic_load(p, __ATOMIC_RELAXED, __HIP_MEMORY_SCOPE_AGENT); }
__device__ __forceinline__ unsigned xb_add(unsigned* p, unsigned v) { return __hip_atomic_fetch_add(p, v, __ATOMIC_RELAXED, __HIP_MEMORY_SCOPE_AGENT); }
__device__ __forceinline__ unsigned xb_xcc_id() { return (unsigned)__builtin_amdgcn_s_getreg((3 << 11) | 20) & 0xFu; }
#define XB_SPIN(cond, bar) do { unsigned _sp = 0; while (cond) { __builtin_amdgcn_s_sleep(1); \
    if ((++_sp & 255u) == 0u) { if (xb_ld(&(bar)[XB_TMO])) break; if (_sp > XB_SPIN_CAP) { atomicAdd(&(bar)[XB_TMO], 1u); break; } } } } while (0)

struct XcdBarrier {
    unsigned* bar; unsigned x;
    volatile LAS unsigned* st;
};

__device__ __forceinline__ XcdBarrier xcd_barrier_post(unsigned* bar, volatile LAS unsigned* st) {
    XcdBarrier b; b.bar = bar; b.x = xb_xcc_id(); b.st = st;
    if (threadIdx.x == 0) (void)xb_add(&bar[XB_XCNT(b.x)], 1u);
    return b;
}
__device__ __forceinline__ void xb_ld16(const unsigned* p0, unsigned (&c)[16]) {
    asm volatile(
        "global_load_dword %0, %16, off sc1\n\tglobal_load_dword %1, %16, off offset:256 sc1\n\tglobal_load_dword %2, %16, off offset:512 sc1\n\tglobal_load_dword %3, %16, off offset:768 sc1\n\t"
        "global_load_dword %4, %16, off offset:1024 sc1\n\tglobal_load_dword %5, %16, off offset:1280 sc1\n\tglobal_load_dword %6, %16, off offset:1536 sc1\n\tglobal_load_dword %7, %16, off offset:1792 sc1\n\t"
        "global_load_dword %8, %16, off offset:2048 sc1\n\tglobal_load_dword %9, %16, off offset:2304 sc1\n\tglobal_load_dword %10, %16, off offset:2560 sc1\n\tglobal_load_dword %11, %16, off offset:2816 sc1\n\t"
        "global_load_dword %12, %16, off offset:3072 sc1\n\tglobal_load_dword %13, %16, off offset:3328 sc1\n\tglobal_load_dword %14, %16, off offset:3584 sc1\n\tglobal_load_dword %15, %16, off offset:3840 sc1\n\t"
        "s_waitcnt vmcnt(0)"
        : "=&v"(c[0]), "=&v"(c[1]), "=&v"(c[2]), "=&v"(c[3]), "=&v"(c[4]), "=&v"(c[5]), "=&v"(c[6]), "=&v"(c[7]), "=&v"(c[8]), "=&v"(c[9]), "=&v"(c[10]), "=&v"(c[11]), "=&v"(c[12]), "=&v"(c[13]), "=&v"(c[14]), "=&v"(c[15])
        : "v"(p0) : "memory");
}
__device__ __forceinline__ void xcd_barrier_complete(unsigned* bar, unsigned x, unsigned& nloc, unsigned& nx) {
    const unsigned G = gridDim.x * gridDim.y * gridDim.z;
    unsigned sum, cnt, mine, sp = 0u;
    for (;;) {
        sum = 0u; cnt = 0u; mine = 0u;
        unsigned cv[16]; xb_ld16(bar + XB_XCNT(0), cv);
#pragma unroll
        for (unsigned j = 0; j < 16; ++j) { const unsigned c = cv[j]; sum += c; cnt += (c > 0u) ? 1u : 0u; mine = (j == x) ? c : mine; }
        if (sum == G) break;
        __builtin_amdgcn_s_sleep(1);
        if ((++sp & 255u) == 0u) { if (xb_ld(&bar[XB_TMO])) break; if (sp > XB_SPIN_CAP) { atomicAdd(&bar[XB_TMO], 1u); break; } }
    }
    nloc = mine > 0u ? mine : 1u; nx = cnt > 0u ? cnt : 1u;
}

__device__ __forceinline__ void xcd_barrier(const XcdBarrier& b) {
    asm volatile("s_waitcnt vmcnt(0)" ::: "memory");
    __syncthreads();
    if (threadIdx.x == 0) {
        unsigned* bar = b.bar;
        __builtin_amdgcn_s_waitcnt(0);
        unsigned nloc = b.st[0], nx = b.st[1];
        if (nloc == 0u) { xcd_barrier_complete(bar, b.x, nloc, nx); b.st[0] = nloc; b.st[1] = nx; }
        const unsigned old = xb_add(&bar[XB_XSUB(b.x)], 1u);
        const unsigned gen = old / nloc;
        if (old + 1u == (gen + 1u) * nloc) {
            __builtin_amdgcn_fence(__ATOMIC_RELEASE, "agent");
            asm volatile("s_waitcnt vmcnt(0)" ::: "memory");
            const unsigned og = xb_add(&bar[XB_TOP], 1u);
            const unsigned tg = og / nx;
            if (og + 1u == (tg + 1u) * nx) xb_add(&bar[XB_TOPGEN], 1u);
            else XB_SPIN(xb_ld(&bar[XB_TOPGEN]) == tg, bar);
            __builtin_amdgcn_fence(__ATOMIC_ACQUIRE, "agent");
            xb_add(&bar[XB_XGEN(b.x)], 1u);
            asm volatile("s_waitcnt vmcnt(0)" ::: "memory");
        } else {
            XB_SPIN(xb_ld(&bar[XB_XGEN(b.x)]) == gen, bar);
            __builtin_amdgcn_fence(__ATOMIC_ACQUIRE, "agent");
            asm volatile("s_waitcnt vmcnt(0)" ::: "memory");
        }
    }
    __syncthreads();
}


constexpr int LDS_BYTES = 147456;
constexpr int LDS_MISC = 131072;
namespace gm {
typedef short bf16x8 __attribute__((ext_vector_type(8)));
typedef float f32x4 __attribute__((ext_vector_type(4)));
typedef unsigned u32x4 __attribute__((ext_vector_type(4)));
constexpr int BM = 256, BK = 64, HALF = 128, HTB = HALF * BK * 2, STAGE_BYTES = 8 * HTB, NXCD = 8, WGM = 8;
__device__ __forceinline__ int lds_byte(int r, int c) { const int st = (r >> 4) * 2 + (c >> 5), rr = r & 15, cc = c & 31, ob = rr * 64 + cc * 2; return st * 1024 + (ob ^ (((ob >> 9) & 1) << 5)); }
__device__ __forceinline__ void stage_rc(int b, int& R, int& C) { const int st = b / 1024, sb = b % 1024, swz = sb ^ (((sb >> 9) & 1) << 5); R = (st >> 1) * 16 + swz / 64; C = (st & 1) * 32 + (swz % 64) / 2; }
__device__ __forceinline__ int perm32(int rho) { const int n = rho >> 4, i = rho & 15; return 8 * (i >> 2) + 4 * n + (i & 3); }
__device__ __forceinline__ unsigned cvt_pk_bf16(float lo, float hi) {
    typedef __bf16 bf2_t __attribute__((ext_vector_type(2))); typedef float f2_t __attribute__((ext_vector_type(2)));
    const bf2_t r = __builtin_convertvector((f2_t){lo, hi}, bf2_t); return __builtin_bit_cast(unsigned, r); }
__device__ __forceinline__ float fsigmoid(float x) { return __builtin_amdgcn_rcpf(1.0f + __expf(-x)); }

typedef int i32x2 __attribute__((ext_vector_type(2)));
struct GUnit { const char* B; int arow0, pm, pn, e, cnt, tb; };

template <int MT, class Epi, class Sched>
__device__ __forceinline__ void gemm_phase(LAS unsigned char* lds, const char* A0, const int K, const Sched& S, const Epi& E) {
    int tid_ = threadIdx.x; asm volatile("" : "+v"(tid_));
    const int tid = tid_, wid = __builtin_amdgcn_readfirstlane(tid >> 6), lane = tid & 63, wr = wid >> 2, wc = wid & 3, fr = lane & 15, fq = lane >> 4;
    const int nt = K / BK;
    int R0, C0; stage_rc(tid * 16, R0, C0);
    const unsigned voffB = (unsigned)(((R0 & ~31) + perm32(R0 & 31)) * K + C0) * 2u;
    const size_t qstep = (size_t)64 * K * 2;
    const size_t astep = (size_t)(16 * MT) * K * 2;
    const size_t kstep = (size_t)(BK * 2);
    const size_t hstep = (size_t)HALF * K * 2;
    const unsigned ldsw = (unsigned)wid * 1024u;
    const int aoff = lds_byte(wr * 64 + fr, fq * 8), boff = lds_byte(wc * 32 + fr, fq * 8);
#define PG8_SA(b, h) (((b) * 2 + (h)) * HTB)
#define PG8_SB(b, h) ((4 + (b) * 2 + (h)) * HTB)
#define PG8_STAGEB(bufoff, gbase) do { _Pragma("unroll") for (int _i = 0; _i < 2; ++_i) \
        __builtin_amdgcn_global_load_lds((const unsigned*)((const char*)(gbase) + _i * qstep + voffB), (LAS unsigned*)(lds + (bufoff) + ldsw + _i * 8192), 16, 0, 0); } while (0)
#define PG8_STAGEA(bufoff, kbyte, h) do { _Pragma("unroll") for (int _i = 0; _i < 2; ++_i) { \
        const char* _src = Sched::GATHER ? A0 + (size_t)va[(h) * 2 + _i] + (size_t)(kbyte) : A0 + ((size_t)(kbyte) + ((h) * 2 + _i) * astep) + (size_t)va[0]; \
        __builtin_amdgcn_global_load_lds((const unsigned*)_src, (LAS unsigned*)(lds + (bufoff) + ldsw + _i * 8192), 16, 0, 0); } } while (0)
#define PG8_LDA(dst, b, h) do { _Pragma("unroll") for (int m = 0; m < MT; ++m) _Pragma("unroll") for (int k = 0; k < 2; ++k) dst[m][k] = *(const LAS bf16x8*)(lds + PG8_SA(b, h) + aoff + m * 2048 + k * 1024); } while (0)
#define PG8_LDB(dst, b, h) do { _Pragma("unroll") for (int n = 0; n < 2; ++n) _Pragma("unroll") for (int k = 0; k < 2; ++k) dst[n][k] = *(const LAS bf16x8*)(lds + PG8_SB(b, h) + boff + n * 2048 + k * 1024); } while (0)
#define PG8_MMA(ai, bj, At, Bt) do { __builtin_amdgcn_s_setprio(1); _Pragma("unroll") for (int m = 0; m < MT; ++m) _Pragma("unroll") for (int n = 0; n < 2; ++n) _Pragma("unroll") for (int k = 0; k < 2; ++k) \
        acc[ai][bj][m][n] = __builtin_amdgcn_mfma_f32_16x16x32_bf16(Bt[n][k], At[m][k], acc[ai][bj][m][n], 0, 0, 0); __builtin_amdgcn_s_setprio(0); } while (0)
#define PG8_WAIT_V(n) asm volatile("s_waitcnt vmcnt(" #n ")" ::: "memory")
#define PG8_WAIT_L(n) asm volatile("s_waitcnt lgkmcnt(" #n ")" ::: "memory")
#define PG8_BAR __builtin_amdgcn_s_barrier()
#define PG8_SCHED __builtin_amdgcn_sched_barrier(0)
#define PG8_AOFFS(dst, u) do { _Pragma("unroll") for (int _h = 0; _h < 2; ++_h) _Pragma("unroll") for (int _i = 0; _i < 2; ++_i) \
        if (Sched::GATHER || (_h + _i == 0)) dst[_h * 2 + _i] = ((unsigned)S.arow(u, _h * 128 + _i * 64 + R0) * (unsigned)K + (unsigned)C0) * 2u; } while (0)
    GUnit cur, nxt; int ui = 0;
    if (!S.next(0, cur)) return;
    f32x4 acc[2][2][MT][2];
#pragma unroll
    for (int a = 0; a < 2; ++a)
#pragma unroll
        for (int b = 0; b < 2; ++b)
#pragma unroll
            for (int m = 0; m < MT; ++m)
#pragma unroll
                for (int n = 0; n < 2; ++n) acc[a][b][m][n] = (f32x4){0.f, 0.f, 0.f, 0.f};
    bf16x8 At[MT][2], B0[2][2], B1[2][2];
    unsigned va[4], vn[4] = {0u, 0u, 0u, 0u};
    PG8_AOFFS(va, cur);
    const char* cB = cur.B;
    PG8_STAGEB(PG8_SB(0, 0), cB); PG8_STAGEB(PG8_SB(0, 1), cB + hstep); PG8_STAGEA(PG8_SA(0, 0), 0, 0); PG8_STAGEA(PG8_SA(0, 1), 0, 1);
    if (wr == 1) PG8_BAR;
    PG8_WAIT_V(2); PG8_BAR;
    PG8_STAGEB(PG8_SB(1, 0), cB + kstep); PG8_STAGEA(PG8_SA(1, 0), kstep, 0); PG8_STAGEB(PG8_SB(1, 1), cB + hstep + kstep);
    PG8_WAIT_V(6); PG8_BAR;
    for (;;) {
        const bool has_next = S.next(ui + 1, nxt);
        const char* nB = has_next ? nxt.B : cB;
        for (int t = 0; t < nt; t += 2) {
            const bool last = (t == nt - 2);
            const size_t k1 = (size_t)(t + 1) * kstep;
            const size_t k2 = last ? (size_t)0 : (size_t)(t + 2) * kstep; const char* b2 = last ? nB : cB + (size_t)(t + 2) * kstep;
            const size_t k3 = k2 + kstep; const char* b3 = b2 + kstep;
            PG8_LDB(B0, 0, 0); PG8_LDB(B1, 0, 1); PG8_SCHED; PG8_LDA(At, 0, 0); PG8_STAGEA(PG8_SA(1, 1), k1, 1);
            if (Sched::GATHER) {
                if (t == nt - 4 && has_next) { PG8_AOFFS(vn, nxt); }
                if (last && has_next) { _Pragma("unroll") for (int _k = 0; _k < 4; ++_k) va[_k] = vn[_k]; } }
            else if (last && has_next) { PG8_AOFFS(va, nxt); }
            PG8_WAIT_V(8); PG8_WAIT_L(0); PG8_BAR; PG8_MMA(0, 0, At, B0); PG8_MMA(0, 1, At, B1); PG8_BAR; PG8_SCHED;
            PG8_LDA(At, 0, 1); PG8_STAGEB(PG8_SB(0, 0), b2); PG8_STAGEB(PG8_SB(0, 1), b2 + hstep); PG8_STAGEA(PG8_SA(0, 0), k2, 0);
            PG8_WAIT_V(8); PG8_WAIT_L(0); PG8_BAR; PG8_MMA(1, 0, At, B0); PG8_MMA(1, 1, At, B1); PG8_BAR; PG8_SCHED;
            PG8_LDB(B0, 1, 0); PG8_LDB(B1, 1, 1); PG8_SCHED; PG8_LDA(At, 1, 0); PG8_STAGEA(PG8_SA(0, 1), k2, 1);
            PG8_WAIT_V(8); PG8_WAIT_L(0); PG8_BAR; PG8_MMA(0, 0, At, B0); PG8_MMA(0, 1, At, B1); PG8_BAR; PG8_SCHED;
            PG8_LDA(At, 1, 1); PG8_STAGEB(PG8_SB(1, 0), b3); PG8_STAGEB(PG8_SB(1, 1), b3 + hstep); PG8_STAGEA(PG8_SA(1, 0), k3, 0);
            PG8_WAIT_V(8); PG8_WAIT_L(0); PG8_BAR; PG8_MMA(1, 0, At, B0); PG8_MMA(1, 1, At, B1); PG8_BAR; PG8_SCHED;
        }
        if (wr == 0) PG8_BAR;
        E(acc, cur, wr, wc, fr, fq);
        if (!has_next) break;
#pragma unroll
        for (int a = 0; a < 2; ++a)
#pragma unroll
            for (int b = 0; b < 2; ++b)
#pragma unroll
                for (int m = 0; m < MT; ++m)
#pragma unroll
                    for (int n = 0; n < 2; ++n) acc[a][b][m][n] = (f32x4){0.f, 0.f, 0.f, 0.f};
        cur = nxt; cB = nB; ++ui;
        if (wr == 1) PG8_BAR;
    }
    PG8_WAIT_V(0);
    PG8_BAR;
#undef PG8_SA
#undef PG8_SB
#undef PG8_STAGEA
#undef PG8_STAGEB
#undef PG8_LDA
#undef PG8_LDB
#undef PG8_MMA
#undef PG8_WAIT_V
#undef PG8_WAIT_L
#undef PG8_BAR
#undef PG8_SCHED
#undef PG8_AOFFS
}

struct DenseSched {
    static constexpr bool GATHER = false;
    const char* Bt; int K, nM, nN, G, c, latent_only, trows;
    __device__ __forceinline__ bool next(int i, GUnit& u) const {
        const int nwg = nM * nN; const long L = (long)i * G + c; if (L >= nwg) return false;
        int wgid = (int)L; { const int q = nwg / NXCD, r = nwg % NXCD, xcd = wgid % NXCD, off = wgid / NXCD; wgid = (xcd < r ? xcd * (q + 1) : r * (q + 1) + (xcd - r) * q) + off; }
        const int nig = WGM * nN, gid = wgid / nig, fm = gid * WGM, gsz = (nM - fm) < WGM ? (nM - fm) : WGM;
        int pm = fm + ((wgid % nig) % gsz); const int pn = (wgid % nig) / gsz;
        if (latent_only) pm = (pm / 8) * 9 + 1 + (pm % 8);
        u.pm = pm; u.pn = pn; u.arow0 = pm * trows; u.B = Bt + (size_t)pn * 256 * K * 2; u.e = 0; u.cnt = 0; u.tb = 0; return true;
    }
    __device__ __forceinline__ int arow(const GUnit& u, int rloc) const { return u.arow0 + rloc; }
    __device__ __forceinline__ bool short_a_round() const { const int nwg = nM * nN, T = nwg % G; return T > 0 && c >= T; }
};
template <bool GATHER_> struct MoeSched {
    static constexpr bool GATHER = GATHER_;
    const char* Wt; size_t wstride; const int* ecnt; const i32x2* elist; int K, nN, G, c; LAS int* tab; int ntile;
    __device__ __forceinline__ void init() {
        if (threadIdx.x == 0) {
            int acc = 0;
            for (int e = 0; e < NE; ++e) { const int cc = __hip_atomic_load(ecnt + e, __ATOMIC_RELAXED, __HIP_MEMORY_SCOPE_AGENT); tab[e] = acc; tab[17 + e] = cc; acc += (cc + 255) / 256; }
            tab[NE] = acc;
        }
        __syncthreads();
        ntile = __builtin_amdgcn_readfirstlane(tab[NE]);
    }
    __device__ __forceinline__ void reuse() { ntile = __builtin_amdgcn_readfirstlane(tab[NE]); }
    __device__ __forceinline__ bool next(int i, GUnit& u) const {
        const int x = c & 7, w = c >> 3, G8 = G >> 3, tb0 = ntile / 8, rem = ntile % 8, ntx = tb0 + (x < rem ? 1 : 0), start = x * tb0 + (x < rem ? x : rem);
        const int v = i * G8 + w; if (v >= ntx * nN) return false;
        const int tile = start + v / nN, pn = v % nN; int e_ = 0;
        for (int e = 1; e < NE; ++e) { if (__builtin_amdgcn_readfirstlane(tab[e]) <= tile) e_ = e; }
        const int tb_ = __builtin_amdgcn_readfirstlane(tab[e_]), cnt_ = __builtin_amdgcn_readfirstlane(tab[17 + e_]);
        u.pm = tile; u.pn = pn; u.e = e_; u.tb = tb_; u.cnt = cnt_ - (tile - tb_) * 256; u.arow0 = tile * 256;
        u.B = Wt + (size_t)e_ * wstride + (size_t)pn * 256 * K * 2; return true;
    }
    __device__ __forceinline__ bool short_a_round() const { const int x = c & 7, w = c >> 3, G8 = G >> 3, tb0 = ntile / 8, rem = ntile % 8, ntx = tb0 + (x < rem ? 1 : 0), T = (ntx * nN) % G8; return T > 0 && w >= T; }
    __device__ __forceinline__ int arow(const GUnit& u, int rloc) const {
        if (!GATHER) return u.arow0 + rloc;
        const int pos = (u.pm - u.tb) * 256 + rloc;
        return rloc < u.cnt ? (elist[(size_t)u.e * MROWS + pos].x >> 1) : 0;
    }
};

#define EPI_ROWS(...) _Pragma("unroll") for (int ai = 0; ai < 2; ++ai) _Pragma("unroll") for (int m = 0; m < MT; ++m) { const int rloc = ai * (32 * MT) + wr * (16 * MT) + m * 16 + fr; __VA_ARGS__ }
__device__ __forceinline__ void store8(bf16* dst, const f32x4 v0, const f32x4 v1) {
    u32x4 w; w.x = cvt_pk_bf16(v0[0], v0[1]); w.y = cvt_pk_bf16(v0[2], v0[3]); w.z = cvt_pk_bf16(v1[0], v1[1]); w.w = cvt_pk_bf16(v1[2], v1[3]); *(u32x4*)dst = w;
}
__device__ __forceinline__ unsigned pk4_f8(const f32x4 v) {
    int w = __builtin_amdgcn_cvt_pk_fp8_f32(__builtin_amdgcn_fmed3f(v[0], -448.0f, 448.0f), __builtin_amdgcn_fmed3f(v[1], -448.0f, 448.0f), 0, false);
    w = __builtin_amdgcn_cvt_pk_fp8_f32(__builtin_amdgcn_fmed3f(v[2], -448.0f, 448.0f), __builtin_amdgcn_fmed3f(v[3], -448.0f, 448.0f), w, true); return (unsigned)w; }
__device__ __forceinline__ void store8_f8(unsigned char* dst, const f32x4 v0, const f32x4 v1) {
    typedef unsigned u32x2_ __attribute__((ext_vector_type(2))); u32x2_ w; w.x = pk4_f8(v0); w.y = pk4_f8(v1); *(u32x2_*)dst = w; }
struct EpiG1M {
    bf16 *Q, *Kb, *V, *O; float* GT; const float* bgate;
    template <int MT> __device__ __forceinline__ void operator()(const f32x4 (&acc)[2][2][MT][2], const GUnit& u, int wr, int wc, int fr, int fq) const {
        const int pn = u.pn;
        if (pn < 12) {
            bf16* base; int ld, colt; float sc = 1.0f; bool sig = false;
            if (pn < 2) { base = Q; ld = QKW; colt = pn * 256; sc = 0.125f; } else if (pn < 4) { base = Kb; ld = QKW; colt = (pn - 2) * 256; }
            else if (pn < 8) { base = V; ld = VW; colt = (pn - 4) * 256; } else { base = O; ld = VW; colt = (pn - 8) * 256; sig = true; }
            const int col0 = colt + wc * 32 + 8 * fq;
            EPI_ROWS(
                bf16* rowp = base + (size_t)(u.arow0 + rloc) * ld + col0;
                _Pragma("unroll") for (int bj = 0; bj < 2; ++bj) { f32x4 v0 = acc[ai][bj][m][0] * sc, v1 = acc[ai][bj][m][1] * sc;
                    if (sig) { _Pragma("unroll") for (int q = 0; q < 4; ++q) { v0[q] = fsigmoid(v0[q]); v1[q] = fsigmoid(v1[q]); } }
                    store8(rowp + bj * 128, v0, v1); }
            )
        } else if (wc == 0) {
            EPI_ROWS(
                float* rowp = GT + (size_t)(u.arow0 + rloc) * 32 + 8 * fq;
                _Pragma("unroll") for (int n = 0; n < 2; ++n) { f32x4 v = acc[ai][0][m][n];
                    _Pragma("unroll") for (int q = 0; q < 4; ++q) { float x = v[q] + bgate[8 * fq + 4 * n + q]; if (fq & 1) x = logsigmoidf_(x); v[q] = x; }
                    *(f32x4*)(rowp + 4 * n) = v; }
            )
        }
    }
};
struct EpiG1R {
    bf16 *GY, *XR;
    template <int MT> __device__ __forceinline__ void operator()(const f32x4 (&acc)[2][2][MT][2], const GUnit& u, int wr, int wc, int fr, int fq) const {
        const int pn = u.pn; const bool act = pn < 4; bf16* base = act ? GY : XR; const int col0 = (act ? pn : pn - 4) * 256 + wc * 32 + 8 * fq;
        EPI_ROWS(
            bf16* rowp = base + (size_t)(u.arow0 + rloc) * D + col0;
            _Pragma("unroll") for (int bj = 0; bj < 2; ++bj) { f32x4 v0 = acc[ai][bj][m][0], v1 = acc[ai][bj][m][1];
                if (act) { _Pragma("unroll") for (int q = 0; q < 4; ++q) {
                    float x = v0[q]; v0[q] = x * fsigmoid(1.5957691216057308f * (x + 0.044715f * x * x * x));
                    x = v1[q]; v1[q] = x * fsigmoid(1.5957691216057308f * (x + 0.044715f * x * x * x)); } }
                store8(rowp + bj * 128, v0, v1); }
        )
    }
};
struct EpiPlain {
    bf16* O; int ld;
    template <int MT> __device__ __forceinline__ void operator()(const f32x4 (&acc)[2][2][MT][2], const GUnit& u, int wr, int wc, int fr, int fq) const {
        const int col0 = u.pn * 256 + wc * 32 + 8 * fq;
        EPI_ROWS(
            bf16* rowp = O + (size_t)(u.arow0 + rloc) * ld + col0;
            _Pragma("unroll") for (int bj = 0; bj < 2; ++bj) store8(rowp + bj * 128, acc[ai][bj][m][0], acc[ai][bj][m][1]);
        )
    }
};
struct EpiG3 {
    bf16* U;
    template <int MT> __device__ __forceinline__ void operator()(const f32x4 (&acc)[2][2][MT][2], const GUnit& u, int wr, int wc, int fr, int fq) const {
        const int col0 = u.pn * 128 + wc * 32 + 8 * fq;
        EPI_ROWS(
            f32x4 v0, v1;
            _Pragma("unroll") for (int q = 0; q < 4; ++q) { const float a0 = acc[ai][0][m][0][q], a1 = acc[ai][0][m][1][q];
                v0[q] = a0 * fsigmoid(a0) * acc[ai][1][m][0][q]; v1[q] = a1 * fsigmoid(a1) * acc[ai][1][m][1][q]; }
            store8(U + (size_t)(u.arow0 + rloc) * DE + col0, v0, v1);
        )
    }
};
struct EpiG4 {
    unsigned char* Y; const i32x2* elist;
    template <int MT> __device__ __forceinline__ void operator()(const f32x4 (&acc)[2][2][MT][2], const GUnit& u, int wr, int wc, int fr, int fq) const {
        const int col0 = u.pn * 256 + wc * 32 + 8 * fq;
        int ent[2][MT]; float tw[2][MT];
        EPI_ROWS( const i32x2 et = rloc < u.cnt ? elist[(size_t)u.e * MROWS + (u.pm - u.tb) * 256 + rloc] : (i32x2){-1, 0}; const int e0_ = et.x, e1_ = et.y; ent[ai][m] = e0_; tw[ai][m] = __builtin_bit_cast(float, e1_); )
        EPI_ROWS(
            if (ent[ai][m] >= 0) { unsigned char* rowp = Y + (size_t)ent[ai][m] * D + col0; const float t = tw[ai][m];
                _Pragma("unroll") for (int bj = 0; bj < 2; ++bj) store8_f8(rowp + bj * 128, acc[ai][bj][m][0] * t, acc[ai][bj][m][1] * t); }
        )
    }
};
}

__device__ __forceinline__ bool o_g1(const Params& p, int i, LAS unsigned char* lds) {
    const int j = i >> 1;
    if ((i & 1) == 0) {
        gm::DenseSched S{(const char*)(WSP(bf16, WS_WINM) + (size_t)j * MPROJ_P * D), D, MROWS / 256, MPROJ_P / 256, (int)gridDim.x, (int)blockIdx.x, 0, 256};
        gm::EpiG1M E{WSP(bf16, WS_Q), WSP(bf16, WS_K), WSP(bf16, WS_V), WSP(bf16, WS_O), WSP(float, WS_GT), p.m_b_gate + j * 4 * NH};
        gm::gemm_phase<4>(lds, (const char*)WSP(bf16, WS_HB), D, S, E);
        return S.short_a_round();
    } else {
        gm::DenseSched S{(const char*)(WSP(bf16, WS_WINR) + (size_t)j * 2 * D * D), D, MROWS / 192, 2 * D / 256, (int)gridDim.x, (int)blockIdx.x, 0, 192};
        gm::EpiG1R E{WSP(bf16, WS_GY), WSP(bf16, WS_XR)};
        gm::gemm_phase<3>(lds, (const char*)WSP(bf16, WS_HB), D, S, E);
        return S.short_a_round();
    }
}
__device__ __forceinline__ bool o_g2(const Params& p, int i, LAS unsigned char* lds) {
    const int j = i >> 1; const bool lastl = (i == DEPTH - 1);
    const bf16* W = (i & 1) ? WSP(bf16, WS_WOUTR) + (size_t)j * D * D : WSP(bf16, WS_WOUTM) + (size_t)j * D * VW;
    gm::EpiPlain E{WSP(bf16, WS_HB), D};
    if (lastl) {
        gm::DenseSched S{(const char*)W, RBK, NB * 8, D / 256, (int)gridDim.x, (int)blockIdx.x, 1, 256};
        gm::gemm_phase<4>(lds, (const char*)WSP(bf16, WS_RB), RBK, S, E);
        return S.short_a_round();
    } else {
        gm::DenseSched S{(const char*)W, RBK, MROWS / 192, D / 256, (int)gridDim.x, (int)blockIdx.x, 0, 192};
        gm::gemm_phase<3>(lds, (const char*)WSP(bf16, WS_RB), RBK, S, E);
        return S.short_a_round();
    }
}
__device__ __forceinline__ bool o_g3(const Params& p, int i, LAS unsigned char* lds) {
    gm::MoeSched<true> S{(const char*)(WSP(bf16, WS_W13) + (size_t)i * NE * 2 * DE * D), (size_t)2 * DE * D * 2, WSP(int, WS_CTL) + CW_ECNT + i * NE, WSP(gm::i32x2, WS_ELIST), D, 2 * DE / 256, (int)gridDim.x, (int)blockIdx.x, (LAS int*)(lds + LDS_MISC + 256), 0};
    S.init();
    gm::EpiG3 E{WSP(bf16, WS_U)};
    gm::gemm_phase<4>(lds, (const char*)WSP(bf16, WS_RB), D, S, E);
    return S.short_a_round();
}
__device__ __forceinline__ bool o_g4(const Params& p, int i, LAS unsigned char* lds, const bool have_tab) {
    gm::MoeSched<false> S{(const char*)(WSP(bf16, WS_W2) + (size_t)i * NE * D * DE), (size_t)D * DE * 2, WSP(int, WS_CTL) + CW_ECNT + i * NE, WSP(gm::i32x2, WS_ELIST), DE, D / 256, (int)gridDim.x, (int)blockIdx.x, (LAS int*)(lds + LDS_MISC + 256), 0};
    if (have_tab) S.reuse(); else S.init();
    gm::EpiG4 E{WSP(unsigned char, WS_Y), WSP(gm::i32x2, WS_ELIST)};
    gm::gemm_phase<4>(lds, (const char*)WSP(bf16, WS_U), DE, S, E);
    return S.short_a_round();
}

typedef float f32x4t __attribute__((ext_vector_type(4)));
typedef float f32x2 __attribute__((ext_vector_type(2)));
typedef unsigned u32x2t __attribute__((ext_vector_type(2)));
typedef unsigned u32x4t __attribute__((ext_vector_type(4)));
__device__ __forceinline__ float wave_sum(float v) {
    v += __builtin_bit_cast(float, __builtin_amdgcn_update_dpp(0, __builtin_bit_cast(int, v), 0xB1, 0xF, 0xF, true));
    v += __builtin_bit_cast(float, __builtin_amdgcn_update_dpp(0, __builtin_bit_cast(int, v), 0x4E, 0xF, 0xF, true));
    v += __builtin_bit_cast(float, __builtin_amdgcn_update_dpp(0, __builtin_bit_cast(int, v), 0x141, 0xF, 0xF, true));
    v += __builtin_bit_cast(float, __builtin_amdgcn_update_dpp(0, __builtin_bit_cast(int, v), 0x140, 0xF, 0xF, true));
    const int vi = __builtin_bit_cast(int, v);
    return (__builtin_bit_cast(float, __builtin_amdgcn_readlane(vi, 0)) + __builtin_bit_cast(float, __builtin_amdgcn_readlane(vi, 16))) + (__builtin_bit_cast(float, __builtin_amdgcn_readlane(vi, 32)) + __builtin_bit_cast(float, __builtin_amdgcn_readlane(vi, 48)));
}
__device__ __forceinline__ float rsqrt_nr(float x) { const float y = __builtin_amdgcn_rsqf(x); return y * (1.5f - 0.5f * x * y * y); }
__device__ __forceinline__ f32x4t unpack4(u32x2t w) { return (f32x4t){u2f(w.x << 16), u2f(w.x & 0xFFFF0000u), u2f(w.y << 16), u2f(w.y & 0xFFFF0000u)}; }
__device__ __forceinline__ u32x2t pack4(f32x4t v) { return (u32x2t){gm::cvt_pk_bf16(v[0], v[1]), gm::cvt_pk_bf16(v[2], v[3])}; }
__device__ __forceinline__ f32x4t unpack4_f8(const unsigned w) {
    typedef float f2_t_ __attribute__((ext_vector_type(2)));
    const f2_t_ a = __builtin_amdgcn_cvt_pk_f32_fp8((int)w, false), b = __builtin_amdgcn_cvt_pk_f32_fp8((int)w, true); const float a0 = a[0], a1 = a[1], b0 = b[0], b1 = b[1];
    return (f32x4t){a0, a1, b0, b1}; }
static_assert(MROWS % (256 * 8) == 0 || true, "");
constexpr int ROWS_PER_WAVE = MROWS / (256 * 8);

#ifndef HOST_EMU
__device__ __forceinline__ void route16_fast(const float* lg, const float* b_router, int& e0, int& e1, float& w0, float& w1) {
    float mx = lg[0];
#pragma unroll
    for (int e = 1; e < NE; ++e) mx = lg[e] > mx ? lg[e] : mx;
    float sc[NE]; float sum = 0.f;
#pragma unroll
    for (int e = 0; e < NE; ++e) { sc[e] = __expf(lg[e] - mx); sum += sc[e]; }
    const float inv = __builtin_amdgcn_rcpf(sum);
    float gsbest = -3.0e38f; int be0 = 0, be1 = 1; float bs0 = 0.f, bs1 = 0.f;
#pragma unroll
    for (int g = 0; g < 4; ++g) {
        float m1 = -3.0e38f, m2 = -3.0e38f, s1 = 0.f, s2 = 0.f; int i1 = 0, i2 = 0;
#pragma unroll
        for (int i = 0; i < 4; ++i) {
            const float s = sc[4 * g + i] * inv, v = s + b_router[4 * g + i];
            if (v > m1) { m2 = m1; i2 = i1; s2 = s1; m1 = v; i1 = 4 * g + i; s1 = s; }
            else if (v > m2) { m2 = v; i2 = 4 * g + i; s2 = s; }
        }
        const float gs = m1 + m2;
        if (gs > gsbest) { gsbest = gs; be0 = i1; be1 = i2; bs0 = s1; bs1 = s2; }
    }
    e0 = be0; e1 = be1;
    const float t = 1.0f / (bs0 + bs1);
    w0 = bs0 * t; w1 = bs1 * t;
}
#endif
__device__ __forceinline__ void wave_sum16(float (&v)[NE], int lane) {
    const bool b3 = lane & 8, b2 = lane & 4;
    float r8[8], r4[4], r2[2], r1;
#pragma unroll
    for (int j = 0; j < 8; ++j) { const auto t = __builtin_amdgcn_permlane32_swap(__builtin_bit_cast(unsigned, v[j]), __builtin_bit_cast(unsigned, v[j + 8]), false, false); const unsigned t0 = t[0], t1 = t[1]; r8[j] = __builtin_bit_cast(float, t0) + __builtin_bit_cast(float, t1); }
#pragma unroll
    for (int j = 0; j < 4; ++j) { const auto t = __builtin_amdgcn_permlane16_swap(__builtin_bit_cast(unsigned, r8[j]), __builtin_bit_cast(unsigned, r8[j + 4]), false, false); const unsigned t0 = t[0], t1 = t[1]; r4[j] = __builtin_bit_cast(float, t0) + __builtin_bit_cast(float, t1); }
#pragma unroll
    for (int j = 0; j < 2; ++j) { const float keep = b3 ? r4[j + 2] : r4[j], send = b3 ? r4[j] : r4[j + 2]; r2[j] = keep + __builtin_bit_cast(float, __builtin_amdgcn_update_dpp(0, __builtin_bit_cast(int, send), 0x140, 0xF, 0xF, true)); }
    { const float keep = b2 ? r2[1] : r2[0], send = b2 ? r2[0] : r2[1]; r1 = keep + __builtin_bit_cast(float, __builtin_amdgcn_update_dpp(0, __builtin_bit_cast(int, send), 0x141, 0xF, 0xF, true)); }
    r1 += __builtin_bit_cast(float, __builtin_amdgcn_update_dpp(0, __builtin_bit_cast(int, r1), 0x4E, 0xF, 0xF, true));
    r1 += __builtin_bit_cast(float, __builtin_amdgcn_update_dpp(0, __builtin_bit_cast(int, r1), 0xB1, 0xF, 0xF, true));
#pragma unroll
    for (int e = 0; e < NE; ++e) v[e] = __builtin_bit_cast(float, __builtin_amdgcn_readlane(__builtin_bit_cast(int, r1), ((e >> 3) & 1) * 32 + ((e >> 2) & 1) * 16 + ((e >> 1) & 1) * 8 + (e & 1) * 4));
}
__device__ __forceinline__ float wave_sum16_l(const float (&v)[NE], int lane) {
    const bool b3 = lane & 8, b2 = lane & 4;
    float r8[8], r4[4], r2[2], r1;
#pragma unroll
    for (int j = 0; j < 8; ++j) { const auto t = __builtin_amdgcn_permlane32_swap(__builtin_bit_cast(unsigned, v[j]), __builtin_bit_cast(unsigned, v[j + 8]), false, false); const unsigned t0 = t[0], t1 = t[1]; r8[j] = __builtin_bit_cast(float, t0) + __builtin_bit_cast(float, t1); }
#pragma unroll
    for (int j = 0; j < 4; ++j) { const auto t = __builtin_amdgcn_permlane16_swap(__builtin_bit_cast(unsigned, r8[j]), __builtin_bit_cast(unsigned, r8[j + 4]), false, false); const unsigned t0 = t[0], t1 = t[1]; r4[j] = __builtin_bit_cast(float, t0) + __builtin_bit_cast(float, t1); }
#pragma unroll
    for (int j = 0; j < 2; ++j) { const float keep = b3 ? r4[j + 2] : r4[j], send = b3 ? r4[j] : r4[j + 2]; r2[j] = keep + __builtin_bit_cast(float, __builtin_amdgcn_update_dpp(0, __builtin_bit_cast(int, send), 0x140, 0xF, 0xF, true)); }
    { const float keep = b2 ? r2[1] : r2[0], send = b2 ? r2[0] : r2[1]; r1 = keep + __builtin_bit_cast(float, __builtin_amdgcn_update_dpp(0, __builtin_bit_cast(int, send), 0x141, 0xF, 0xF, true)); }
    r1 += __builtin_bit_cast(float, __builtin_amdgcn_update_dpp(0, __builtin_bit_cast(int, r1), 0x4E, 0xF, 0xF, true));
    r1 += __builtin_bit_cast(float, __builtin_amdgcn_update_dpp(0, __builtin_bit_cast(int, r1), 0xB1, 0xF, 0xF, true));
    return r1;
}
#define DPPF_(x, c) __builtin_bit_cast(float, __builtin_amdgcn_update_dpp(0, __builtin_bit_cast(int, (x)), (c), 0xF, 0xF, true))
#define DPPI_(x, c) __builtin_amdgcn_update_dpp(0, (x), (c), 0xF, 0xF, true)
#define RLF_(x, l) __builtin_bit_cast(float, __builtin_amdgcn_readlane(__builtin_bit_cast(int, (x)), (l)))
__device__ __forceinline__ void route16_l(const float lgv, const int lane, const float mybias, int& e0, int& e1, float& w0, float& w1) {
    const int e = lane >> 2;
    float m = fmaxf(lgv, DPPF_(lgv, 0x141)); m = fmaxf(m, DPPF_(m, 0x140));
    const float mx = fmaxf(fmaxf(RLF_(m, 0), RLF_(m, 16)), fmaxf(RLF_(m, 32), RLF_(m, 48)));
    const float sc = __expf(lgv - mx);
    float rs = sc + DPPF_(sc, 0x141); rs += DPPF_(rs, 0x140);
    const float sum = (RLF_(rs, 0) + RLF_(rs, 16)) + (RLF_(rs, 32) + RLF_(rs, 48));
    const float s = sc * __builtin_amdgcn_rcpf(sum), v = s + mybias;
    float m1 = fmaxf(v, DPPF_(v, 0x141)); m1 = fmaxf(m1, DPPF_(m1, 0x140));
    int c1 = v == m1 ? e : 99; { const int t = DPPI_(c1, 0x141); c1 = t < c1 ? t : c1; } { const int t = DPPI_(c1, 0x140); c1 = t < c1 ? t : c1; }
    const float v2 = e == c1 ? -3.0e38f : v;
    float m2 = fmaxf(v2, DPPF_(v2, 0x141)); m2 = fmaxf(m2, DPPF_(m2, 0x140));
    int c2 = v2 == m2 ? e : 99; { const int t = DPPI_(c2, 0x141); c2 = t < c2 ? t : c2; } { const int t = DPPI_(c2, 0x140); c2 = t < c2 ? t : c2; }
    const float gs = m1 + m2;
    const float g0 = RLF_(gs, 0), g1 = RLF_(gs, 16), g2 = RLF_(gs, 32), g3 = RLF_(gs, 48);
    int gb = 0; float gbest = g0; if (g1 > gbest) { gbest = g1; gb = 1; } if (g2 > gbest) { gbest = g2; gb = 2; } if (g3 > gbest) { gb = 3; }
    const int gbu = __builtin_amdgcn_readfirstlane(gb);
    e0 = __builtin_amdgcn_readlane(c1, gbu * 16); e1 = __builtin_amdgcn_readlane(c2, gbu * 16);
    const float bs0 = RLF_(s, e0 * 4), bs1 = RLF_(s, e1 * 4);
    const float t = 1.0f / (bs0 + bs1);
    w0 = bs0 * t; w1 = bs1 * t;
}
#undef DPPF_
#undef DPPI_
#undef RLF_
__device__ __forceinline__ void o_t1_edge(const Params& p, const int i) {
    int tid_ = threadIdx.x; asm volatile("" : "+v"(tid_));
    const int wid = tid_ >> 6, lane = tid_ & 63, gw = blockIdx.x * 8 + wid;
    bf16* X = WSP(bf16, WS_X); bf16* HB = WSP(bf16, WS_HB); const unsigned char* Y = WSP(unsigned char, WS_Y); const float* MOD = WSP(float, WS_MOD);
    int cur_bp = -1; f32x4t gs[4], sh[4], g5[4], g2p[4];
    float pf[4];
#pragma unroll
    for (int jj = 0; jj < 4; ++jj) pf[jj] = __expf(-9.210340371976184f * (float)(lane * 4 + jj) * (1.0f / (float)(D / 4)));
    for (int rr = 0; rr < ROWS_PER_WAVE; ++rr) {
        const int r = gw * ROWS_PER_WAVE + rr; if (r >= MROWS) break;
        const int b = r / S, s = r % S; const bool isctx = s < CTX; const int bp = isctx ? NB : b;
        if (i == DEPTH && isctx) continue;
        if (bp != cur_bp) {
            cur_bp = bp;
#pragma unroll
            for (int q = 0; q < 4; ++q) { const int k = q * 256 + lane * 4;
                if (i < DEPTH) { const float* mod = MOD + ((size_t)i * (NB + 1) + bp) * 6 * D; const f32x4t gm4 = *(const f32x4t*)(p.g_mix + i * D + k), sc4 = *(const f32x4t*)(mod + D + k);
                    sh[q] = *(const f32x4t*)(mod + k); gs[q] = gm4 * (sc4 + 1.0f); }
                else { gs[q] = *(const f32x4t*)(p.g_final + k); sh[q] = (f32x4t){0.f, 0.f, 0.f, 0.f}; }
                if (i > 0) { g5[q] = *(const f32x4t*)(MOD + ((size_t)(i - 1) * (NB + 1) + bp) * 6 * D + 5 * D + k); g2p[q] = *(const f32x4t*)(MOD + ((size_t)(i - 1) * (NB + 1) + bp) * 6 * D + 2 * D + k); } }
        }
        f32x4t v[4]; float ss = 0.f;
#pragma unroll
        for (int q = 0; q < 4; ++q) { const int k = q * 256 + lane * 4;
            if (i == 0) {
                const float* src = isctx ? p.ctx + ((size_t)b * CTX + s) * D : p.x + ((size_t)b * SEQ + (s - CTX)) * D;
                v[q] = *(const f32x4t*)(src + k);
            } else {
                const unsigned yw0 = *(const unsigned*)(Y + ((size_t)r * 2 + 0) * D + k), yw1 = *(const unsigned*)(Y + ((size_t)r * 2 + 1) * D + k);
                const f32x4t y0 = unpack4_f8(yw0), y1 = unpack4_f8(yw1);
                v[q] = unpack4(*(const u32x2t*)(X + (size_t)r * D + k)) + g2p[q] * unpack4(*(const u32x2t*)(HB + (size_t)r * D + k)) + g5[q] * (y0 + y1);
            }
        }
        if (i == 0 && !isctx) { const int t_ = s - CTX; const float gr_ = (float)(t_ / GRIDW), gc_ = (float)(t_ % GRIDW);
#pragma unroll
            for (int jj = 0; jj < 4; ++jj) { const float ar = gr_ * pf[jj], ac = gc_ * pf[jj]; v[0][jj] += __sinf(ar); v[1][jj] += __cosf(ar); v[2][jj] += __sinf(ac); v[3][jj] += __cosf(ac); } }
#pragma unroll
        for (int q = 0; q < 4; ++q) ss += v[q][0] * v[q][0] + v[q][1] * v[q][1] + v[q][2] * v[q][2] + v[q][3] * v[q][3];
        ss = wave_sum(ss);
        const float rstd = rsqrt_nr(ss * (1.0f / (float)D) + EPS);
#pragma unroll
        for (int q = 0; q < 4; ++q) { const int k = q * 256 + lane * 4;
            if (i == DEPTH) *(f32x4t*)(p.out + ((size_t)b * SEQ + (s - CTX)) * D + k) = v[q] * rstd * gs[q];
            else { *(u32x2t*)(X + (size_t)r * D + k) = pack4(v[q]); *(u32x2t*)(HB + (size_t)r * D + k) = pack4(v[q] * rstd * gs[q] + sh[q]); }
        }
    }
}

#define TK(q) (((q) >> 1) * 512 + lane * 8 + ((q) & 1) * 4)
__device__ __forceinline__ void unpack8(const u32x4t w, f32x4t& lo, f32x4t& hi) { lo = unpack4((u32x2t){w.x, w.y}); hi = unpack4((u32x2t){w.z, w.w}); }
__device__ __forceinline__ u32x4t pack8(const f32x4t lo, const f32x4t hi) { const u32x2t a = pack4(lo), b = pack4(hi); return (u32x4t){a.x, a.y, b.x, b.y}; }
__device__ __forceinline__ void o_t1_mid(const Params& p, const int i) {
    int tid_ = threadIdx.x; asm volatile("" : "+v"(tid_));
    const int wid = tid_ >> 6, lane = tid_ & 63, gw = blockIdx.x * 8 + wid;
    bf16* X = WSP(bf16, WS_X); bf16* HB = WSP(bf16, WS_HB); const unsigned char* Y = WSP(unsigned char, WS_Y); const float* MOD = WSP(float, WS_MOD);
    int cur_bp = -1; f32x4t gs[4], sh[4], g5[4], g2p[4];
    for (int rr = 0; rr < ROWS_PER_WAVE; ++rr) {
        const int r = gw * ROWS_PER_WAVE + rr;
        const int b = r / S, s = r % S; const bool isctx = s < CTX; const int bp = isctx ? NB : b;
        if (bp != cur_bp) {
            cur_bp = bp; const float* mod = MOD + ((size_t)i * (NB + 1) + bp) * 6 * D; const float* modp = MOD + ((size_t)(i - 1) * (NB + 1) + bp) * 6 * D;
#pragma unroll
            for (int q = 0; q < 4; ++q) { const int k = TK(q); const f32x4t gm4 = *(const f32x4t*)(p.g_mix + i * D + k), sc4 = *(const f32x4t*)(mod + D + k);
                sh[q] = *(const f32x4t*)(mod + k); gs[q] = gm4 * (sc4 + 1.0f); g5[q] = *(const f32x4t*)(modp + 5 * D + k); g2p[q] = *(const f32x4t*)(modp + 2 * D + k); }
        }
        f32x4t v[4]; float ss = 0.f;
#pragma unroll
        for (int h = 0; h < 2; ++h) { const int k0 = TK(2 * h);
            const u32x4t xw = *(const u32x4t*)(X + (size_t)r * D + k0), ow = *(const u32x4t*)(HB + (size_t)r * D + k0);
            const u32x2t ya = *(const u32x2t*)(Y + ((size_t)r * 2 + 0) * D + k0), yb = *(const u32x2t*)(Y + ((size_t)r * 2 + 1) * D + k0);
            const unsigned ya0 = ya.x, ya1 = ya.y, yb0 = yb.x, yb1 = yb.y;
            f32x4t x0, x1, o0, o1; unpack8(xw, x0, x1); unpack8(ow, o0, o1); const f32x4t a0 = unpack4_f8(ya0), a1 = unpack4_f8(ya1), b0 = unpack4_f8(yb0), b1 = unpack4_f8(yb1);
            v[2 * h] = x0 + g2p[2 * h] * o0 + g5[2 * h] * (a0 + b0); v[2 * h + 1] = x1 + g2p[2 * h + 1] * o1 + g5[2 * h + 1] * (a1 + b1); }
#pragma unroll
        for (int q = 0; q < 4; ++q) ss += v[q][0] * v[q][0] + v[q][1] * v[q][1] + v[q][2] * v[q][2] + v[q][3] * v[q][3];
        ss = wave_sum(ss);
        const float rstd = rsqrt_nr(ss * (1.0f / (float)D) + EPS);
#pragma unroll
        for (int h = 0; h < 2; ++h) { const int k0 = TK(2 * h);
            *(u32x4t*)(X + (size_t)r * D + k0) = pack8(v[2 * h], v[2 * h + 1]);
            *(u32x4t*)(HB + (size_t)r * D + k0) = pack8(v[2 * h] * rstd * gs[2 * h] + sh[2 * h], v[2 * h + 1] * rstd * gs[2 * h + 1] + sh[2 * h + 1]); }
    }
}
__device__ __forceinline__ void o_t1(const Params& p, const int i) { if (i == 0 || i == DEPTH) o_t1_edge(p, i); else o_t1_mid(p, i); }

constexpr int T2_WT = 0, T2_TAB = 65536;
__device__ __forceinline__ void o_t2(const Params& p, const int i, LAS unsigned char* lds) {
    int tid_ = threadIdx.x; asm volatile("" : "+v"(tid_));
    const int tid = tid_, wid = tid >> 6, lane = tid & 63, gw = blockIdx.x * 8 + wid;
    const bf16* X = WSP(bf16, WS_X); const bf16* HB = WSP(bf16, WS_HB); bf16* RB = WSP(bf16, WS_RB); const float* MOD = WSP(float, WS_MOD);
    gm::i32x2* EL = WSP(gm::i32x2, WS_ELIST); int* ECNT = WSP(int, WS_CTL) + CW_ECNT + i * NE;
    LAS float* WT = (LAS float*)(lds + T2_WT); LAS int* cnt = (LAS int*)(lds + T2_TAB); LAS int* base = cnt + 16; LAS int* ent = cnt + 32; LAS float* entw = (LAS float*)(ent + 8 * ROWS_PER_WAVE * 2);
    u32x4t nxw[2], now_[2];
#define T2_LOAD(r_) do { _Pragma("unroll") for (int h = 0; h < 2; ++h) { nxw[h] = *(const u32x4t*)(X + (size_t)(r_) * D + TK(2 * h)); now_[h] = *(const u32x4t*)(HB + (size_t)(r_) * D + TK(2 * h)); } } while (0)
    T2_LOAD(gw * ROWS_PER_WAVE);
    int cur_bp; f32x4t gs[4], sh[4], g2[4];
    { const int r0_ = gw * ROWS_PER_WAVE; cur_bp = (r0_ % S) < CTX ? NB : r0_ / S; const float* mod = MOD + ((size_t)i * (NB + 1) + cur_bp) * 6 * D;
#pragma unroll
        for (int q = 0; q < 4; ++q) { const int k = TK(q); const f32x4t gm4 = *(const f32x4t*)(p.g_ffn + i * D + k), sc4 = *(const f32x4t*)(mod + 4 * D + k);
            sh[q] = *(const f32x4t*)(mod + 3 * D + k); gs[q] = gm4 * (sc4 + 1.0f); g2[q] = *(const f32x4t*)(mod + 2 * D + k); } }
    const float mybias = p.b_router[lane >> 2];
    for (int it = tid; it < D * NE / 4; it += 512) { const int k = it >> 2, e4 = (it & 3) * 4; const f32x4t w = *(const f32x4t*)(p.w_router + k * NE + e4);
        const int q_ = ((k >> 9) << 1) | ((k >> 2) & 1), ln_ = (k & 511) >> 3, idx = (q_ * 64 + ln_) * 4 + (k & 3);
        WT[(e4 + 0) * D + idx] = w[0]; WT[(e4 + 1) * D + idx] = w[1]; WT[(e4 + 2) * D + idx] = w[2]; WT[(e4 + 3) * D + idx] = w[3]; }
    if (tid < 16) cnt[tid] = 0;
    __syncthreads();
    for (int rr = 0; rr < ROWS_PER_WAVE; ++rr) {
        const int r = gw * ROWS_PER_WAVE + rr, rl = wid * ROWS_PER_WAVE + rr;
        u32x4t cxw[2], cow[2];
#pragma unroll
        for (int h = 0; h < 2; ++h) { cxw[h] = nxw[h]; cow[h] = now_[h]; }
        if (rr + 1 < ROWS_PER_WAVE) T2_LOAD(r + 1);
        const int b = r / S, s = r % S; const bool isctx = s < CTX; const int bp = isctx ? NB : b;
        if (i == DEPTH - 1 && isctx) { if (lane == 0) { int m1 = -1; asm volatile("" : "+v"(m1)); ent[rl * 2] = m1; ent[rl * 2 + 1] = m1; } continue; }
        if (bp != cur_bp) {
            cur_bp = bp; const float* mod = MOD + ((size_t)i * (NB + 1) + bp) * 6 * D;
#pragma unroll
            for (int q = 0; q < 4; ++q) { const int k = TK(q); const f32x4t gm4 = *(const f32x4t*)(p.g_ffn + i * D + k), sc4 = *(const f32x4t*)(mod + 4 * D + k);
                sh[q] = *(const f32x4t*)(mod + 3 * D + k); gs[q] = gm4 * (sc4 + 1.0f); g2[q] = *(const f32x4t*)(mod + 2 * D + k); }
        }
        f32x4t v[4]; float ss = 0.f;
#pragma unroll
        for (int h = 0; h < 2; ++h) {
            f32x4t x0, x1, o0, o1; unpack8(cxw[h], x0, x1); unpack8(cow[h], o0, o1);
            v[2 * h] = x0 + g2[2 * h] * o0; v[2 * h + 1] = x1 + g2[2 * h + 1] * o1; }
#pragma unroll
        for (int q = 0; q < 4; ++q) ss += v[q][0] * v[q][0] + v[q][1] * v[q][1] + v[q][2] * v[q][2] + v[q][3] * v[q][3];
        ss = wave_sum(ss);
        const float rstd = rsqrt_nr(ss * (1.0f / (float)D) + EPS);
        f32x2 lg2[NE];
#pragma unroll
        for (int e = 0; e < NE; ++e) lg2[e] = (f32x2){0.f, 0.f};
#pragma unroll
        for (int q = 0; q < 4; ++q) v[q] = v[q] * rstd * gs[q] + sh[q];
#pragma unroll
        for (int h = 0; h < 2; ++h) *(u32x4t*)(RB + (size_t)r * RBK + TK(2 * h)) = pack8(v[2 * h], v[2 * h + 1]);
#pragma unroll
        for (int q = 0; q < 4; ++q) { const f32x4t h = v[q];
            f32x4t wv[NE];
#pragma unroll
            for (int e = 0; e < NE; ++e) wv[e] = *(const LAS f32x4t*)(WT + e * D + (q * 64 + lane) * 4);
            asm volatile("" ::: "memory");
#pragma unroll
            for (int e = 0; e < NE; ++e) { lg2[e] = (f32x2){h[0], h[1]} * (f32x2){wv[e][0], wv[e][1]} + lg2[e]; lg2[e] = (f32x2){h[2], h[3]} * (f32x2){wv[e][2], wv[e][3]} + lg2[e]; }
        }
        float lg[NE];
#pragma unroll
        for (int e = 0; e < NE; ++e) lg[e] = lg2[e][0] + lg2[e][1];
        const float lgv = wave_sum16_l(lg, lane);
        int e0, e1; float w0, w1; route16_l(lgv, lane, mybias, e0, e1, w0, w1);
        if (lane == 0) { ent[rl * 2] = e0; ent[rl * 2 + 1] = e1; entw[rl * 2] = w0; entw[rl * 2 + 1] = w1; }
    }
#undef T2_LOAD
    if (lane < ROWS_PER_WAVE * 2) { const int idx = wid * ROWS_PER_WAVE * 2 + lane; const int en = ent[idx];
        if (en >= 0) { const int k = __hip_atomic_fetch_add(cnt + en, 1, __ATOMIC_RELAXED, __HIP_MEMORY_SCOPE_WORKGROUP); ent[idx] = en | (k << 8); } }
    __syncthreads();
    if (tid < 16) base[tid] = atomicAdd(ECNT + tid, (int)cnt[tid]);
    __syncthreads();
    if (tid < 8 * ROWS_PER_WAVE * 2) {
        const int en = ent[tid];
        if (en >= 0) { const int e = en & 255, k = en >> 8, rl = tid >> 1, r = (blockIdx.x * 8 + rl / ROWS_PER_WAVE) * ROWS_PER_WAVE + rl % ROWS_PER_WAVE;
            EL[(size_t)e * MROWS + base[e] + k] = (gm::i32x2){r * 2 + (tid & 1), __builtin_bit_cast(int, entw[tid])}; }
    }
    __syncthreads();
}

constexpr int P0_MODU = DEPTH * 6 * D / 32;
constexpr int P0_TA = 2 * (D / 64) * (MPROJ_P / 256), P0_TB = 2 * (VW / 64) * (D / 256), P0_TC = 2 * (D / 64) * (2 * D / 256), P0_TD = 2 * (D / 64) * (D / 256), P0_TE = 32 * (RBW / 64),
              P0_TF = DEPTH * NE * (D / 64) * (DE / 256), P0_TH = DEPTH * NE * (DE / 64) * (D / 256);
constexpr int P0_TILES = P0_TA + P0_TB + P0_TC + P0_TD + P0_TE + 2 * P0_TF + P0_TH;
constexpr int P0_TS = 260;
constexpr int P0_SIL = 73728;
struct TileJob { const float* src; bf16* dst; int N, K, k0, n0, kind; };
__device__ __forceinline__ TileJob tile_job(const Params& p, int t) {
    TileJob J; int kt, nt; J.kind = 0;
    if (t < P0_TA) { const int per = P0_TA / 2, j = t / per, rem = t % per; kt = rem / (MPROJ_P / 256); nt = rem % (MPROJ_P / 256); J.src = p.m_w_in + (size_t)j * D * MPROJ; J.N = MPROJ; J.dst = WSP(bf16, WS_WINM) + (size_t)j * MPROJ_P * D; J.K = D; }
    else if ((t -= P0_TA) < P0_TB) { const int per = P0_TB / 2, j = t / per, rem = t % per; kt = rem / (D / 256); nt = rem % (D / 256); J.src = p.m_w_out + (size_t)j * VW * D; J.N = D; J.dst = WSP(bf16, WS_WOUTM) + (size_t)j * D * VW; J.K = VW; }
    else if ((t -= P0_TB) < P0_TC) { const int per = P0_TC / 2, j = t / per, rem = t % per; kt = rem / (2 * D / 256); nt = rem % (2 * D / 256); J.src = p.r_w_in + (size_t)j * D * 2 * D; J.N = 2 * D; J.dst = WSP(bf16, WS_WINR) + (size_t)j * 2 * D * D; J.K = D; }
    else if ((t -= P0_TC) < P0_TD) { const int per = P0_TD / 2, j = t / per, rem = t % per; kt = rem / (D / 256); nt = rem % (D / 256); J.src = p.r_w_out + (size_t)j * D * D; J.N = D; J.dst = WSP(bf16, WS_WOUTR) + (size_t)j * D * D; J.K = D; }
    else if ((t -= P0_TD) < P0_TE) { const int mi = t / (RBW / 64); kt = t % (RBW / 64); nt = 0; J.src = p.r_w_gate + (size_t)mi * RBW * 2 * RBW; J.N = 2 * RBW; J.dst = WSP(bf16, WS_WG) + (size_t)mi * 2 * RBW * RBW; J.K = RBW; }
    else if ((t -= P0_TE) < 2 * P0_TF) { const int w3 = t >= P0_TF; if (w3) t -= P0_TF; const int per = (D / 64) * (DE / 256), ie = t / per, rem = t % per; kt = rem / (DE / 256); nt = rem % (DE / 256);
        J.src = (w3 ? p.e_w3 : p.e_w1) + (size_t)ie * D * DE; J.N = DE; J.dst = WSP(bf16, WS_W13) + (size_t)ie * 2 * DE * D; J.K = D; J.kind = 1 + w3; }
    else { t -= 2 * P0_TF; const int per = (DE / 64) * (D / 256), ie = t / per, rem = t % per; kt = rem / (D / 256); nt = rem % (D / 256); J.src = p.e_w2 + (size_t)ie * DE * D; J.N = D; J.dst = WSP(bf16, WS_W2) + (size_t)ie * D * DE; J.K = DE; }
    J.k0 = kt * 64; J.n0 = nt * 256; return J;
}
__device__ __forceinline__ void tile_load(const TileJob& J, int tid, f32x4t (&v)[8]) {
#pragma unroll
    for (int it = 0; it < 8; ++it) { const int k = it * 8 + (tid >> 6), n = J.n0 + (tid & 63) * 4; v[it] = (f32x4t){0.f, 0.f, 0.f, 0.f};
        if (n + 3 < J.N) v[it] = *(const f32x4t*)(J.src + (size_t)(J.k0 + k) * J.N + n); }
}
constexpr int P0_DENSE = P0_TA + P0_TB + P0_TC + P0_TD + P0_TE, P0_LAYER_E = 3 * NE * 32, P0_NOW = P0_DENSE + P0_LAYER_E, P0_DEFER = (DEPTH - 1) * P0_LAYER_E;
static_assert(P0_TF == DEPTH * NE * 32 && P0_TH == DEPTH * NE * 32 && P0_TILES == P0_DENSE + 3 * P0_TF, "");
constexpr int CW_FILLQ = 20480;
__device__ __forceinline__ int expert_tile(int L, int d) { const int kind = d / (NE * 32), r = d % (NE * 32); return P0_DENSE + kind * P0_TF + L * (NE * 32) + r; }
__device__ __forceinline__ int p0_tile(int j) { return j < P0_DENSE ? j : expert_tile(0, j - P0_DENSE); }
__device__ __forceinline__ void tile_load_nt(const TileJob& J, int tid, f32x4t (&v)[8]) {
#pragma unroll
    for (int it = 0; it < 8; ++it) { const int k = it * 8 + (tid >> 6), n = J.n0 + (tid & 63) * 4; v[it] = (f32x4t){0.f, 0.f, 0.f, 0.f};
        if (n + 3 < J.N) v[it] = __builtin_nontemporal_load((const f32x4t*)(J.src + (size_t)(J.k0 + k) * J.N + n)); }
}
__device__ __forceinline__ int defer_tile(int t) { return expert_tile(1 + t / P0_LAYER_E, t % P0_LAYER_E); }
__device__ __forceinline__ void convert_run(const Params& p, LAS unsigned char* lds, const int t0, const int n, const int tid) {
    LAS float* T = (LAS float*)lds;
    TileJob Ja = tile_job(p, defer_tile(t0)), Jb = Ja; f32x4t va_[8], vb_[8]; tile_load_nt(Ja, tid, va_);
    if (n > 1) { Jb = tile_job(p, defer_tile(t0 + 1)); tile_load_nt(Jb, tid, vb_); }
#define CV_STEP(Jc_, vc_, nk_) do { \
        _Pragma("unroll") for (int it = 0; it < 8; ++it) *(LAS f32x4t*)(T + (it * 8 + (tid >> 6)) * P0_TS + (((tid & 63) ^ it) * 4)) = vc_[it]; \
        __syncthreads(); \
        const TileJob Jd = Jc_; \
        if ((nk_) < n) { Jc_ = tile_job(p, defer_tile(t0 + (nk_))); tile_load_nt(Jc_, tid, vc_); } \
        _Pragma("unroll") for (int it = 0; it < 4; ++it) { const int item = it * 512 + tid, kg = item & 7, nn = item >> 3; \
            float f[8]; \
            _Pragma("unroll") for (int jj = 0; jj < 8; ++jj) f[jj] = T[(kg * 8 + jj) * P0_TS + (nn ^ (kg << 2))]; \
            const int ng = Jd.n0 + nn; const int drow = Jd.kind == 0 ? ng : (ng / 128) * 256 + (Jd.kind - 1) * 128 + ng % 128; \
            u32x4t w; w.x = gm::cvt_pk_bf16(f[0], f[1]); w.y = gm::cvt_pk_bf16(f[2], f[3]); w.z = gm::cvt_pk_bf16(f[4], f[5]); w.w = gm::cvt_pk_bf16(f[6], f[7]); \
            __builtin_nontemporal_store(w, (u32x4t*)(Jd.dst + (size_t)drow * Jd.K + Jd.k0 + kg * 8)); } \
        __syncthreads(); } while (0)
    for (int k = 0; k < n; k += 2) {
        CV_STEP(Ja, va_, k + 2);
        if (k + 1 >= n) break;
        CV_STEP(Jb, vb_, k + 3);
    }
#undef CV_STEP
}
__device__ __forceinline__ void fill_tiles(const Params& p, LAS unsigned char* lds, const int batch, const int limit, const bool repeat) {
    int tid_ = threadIdx.x; asm volatile("" : "+v"(tid_));
    const int tid = tid_;
    int* q = WSP(int, WS_CTL) + CW_FILLQ; volatile LAS int* tk = (volatile LAS int*)(lds + LDS_MISC + 64);
    for (;;) {
        if (tid == 0) { int t = -1; if (!repeat || __hip_atomic_load(q, __ATOMIC_RELAXED, __HIP_MEMORY_SCOPE_AGENT) < limit) t = __hip_atomic_fetch_add(q, batch, __ATOMIC_RELAXED, __HIP_MEMORY_SCOPE_AGENT); *tk = t; }
        __syncthreads();
        const int t = *tk;
        __syncthreads();
        if (t < 0 || t >= P0_DEFER) break;
        convert_run(p, lds, t, (P0_DEFER - t) < batch ? (P0_DEFER - t) : batch, tid);
        if (!repeat) break;
    }
}
__device__ __forceinline__ void o_p0(const Params& p, LAS unsigned char* lds) {
    int tid_ = threadIdx.x; asm volatile("" : "+v"(tid_));
    const int tid = tid_;
    LAS float* T = (LAS float*)lds; LAS float* SIL = (LAS float*)(lds + P0_SIL); LAS float* RED = SIL + (NB + 1) * D;
    for (int it = tid; it < (NB + 1) * D; it += 512) { const int bp = it / D, k = it % D; SIL[it] = siluf_(bp < NB ? p.c[bp * D + k] : p.c_ctx[k]); }
    __syncthreads();
    float* MOD = WSP(float, WS_MOD);
    for (int job = blockIdx.x; job < P0_MODU; job += gridDim.x) {
        const int i = job / (6 * D / 32), n0 = (job % (6 * D / 32)) * 32, col = tid & 31, ks = tid >> 5;
        float acc[NB + 1];
#pragma unroll
        for (int bp = 0; bp <= NB; ++bp) acc[bp] = 0.f;
        const float* w = p.w_ada + (size_t)i * D * 6 * D + n0 + col;
        float wv[64];
#pragma unroll
        for (int k = 0; k < 64; ++k) wv[k] = w[(size_t)(ks * 64 + k) * 6 * D];
#pragma unroll
        for (int k4 = 0; k4 < 16; ++k4) {
#pragma unroll
            for (int bp = 0; bp <= NB; ++bp) { const f32x4t s4 = *(const LAS f32x4t*)(SIL + bp * D + ks * 64 + 4 * k4);
                acc[bp] = fmaf(s4[3], wv[4 * k4 + 3], fmaf(s4[2], wv[4 * k4 + 2], fmaf(s4[1], wv[4 * k4 + 1], fmaf(s4[0], wv[4 * k4], acc[bp])))); } }
#pragma unroll
        for (int bp = 0; bp <= NB; ++bp) RED[(ks * (NB + 1) + bp) * 32 + col] = acc[bp];
        __syncthreads();
        if (tid < (NB + 1) * 32) { const int bp = tid / 32, c2 = tid % 32; float sum = p.b_ada[i * 6 * D + n0 + c2];
#pragma unroll
            for (int q = 0; q < 16; ++q) sum += RED[(q * (NB + 1) + bp) * 32 + c2];
            MOD[((size_t)i * (NB + 1) + bp) * 6 * D + n0 + c2] = sum; }
        __syncthreads();
    }
    int job = blockIdx.x; if (job >= P0_NOW) return;
    const int stride = (int)gridDim.x;
    TileJob Ja = tile_job(p, p0_tile(job)), Jb = Ja; f32x4t va_[8], vb_[8]; tile_load(Ja, tid, va_);
    bool hasb = job + stride < P0_NOW; if (hasb) { Jb = tile_job(p, p0_tile(job + stride)); tile_load(Jb, tid, vb_); }
#define P0_STEP(Jc_, vc_, nextjob_) do { \
        _Pragma("unroll") for (int it = 0; it < 8; ++it) *(LAS f32x4t*)(T + (it * 8 + (tid >> 6)) * P0_TS + (((tid & 63) ^ it) * 4)) = vc_[it];        \
        __syncthreads(); \
        const TileJob Jd = Jc_; const bool more_ = (nextjob_) < P0_NOW; \
        if (more_) { Jc_ = tile_job(p, p0_tile(nextjob_)); tile_load(Jc_, tid, vc_); } \
        _Pragma("unroll") for (int it = 0; it < 4; ++it) { const int item = it * 512 + tid, kg = item & 7, n = item >> 3; \
            float f[8]; \
            _Pragma("unroll") for (int jj = 0; jj < 8; ++jj) f[jj] = T[(kg * 8 + jj) * P0_TS + (n ^ (kg << 2))]; \
            const int ng = Jd.n0 + n; const int drow = Jd.kind == 0 ? ng : (ng / 128) * 256 + (Jd.kind - 1) * 128 + ng % 128; \
            u32x4t w; w.x = gm::cvt_pk_bf16(f[0], f[1]); w.y = gm::cvt_pk_bf16(f[2], f[3]); w.z = gm::cvt_pk_bf16(f[4], f[5]); w.w = gm::cvt_pk_bf16(f[6], f[7]); \
            *(u32x4t*)(Jd.dst + (size_t)drow * Jd.K + Jd.k0 + kg * 8) = w; } \
        __syncthreads(); } while (0)
    for (;;) {
        P0_STEP(Ja, va_, job + 2 * stride);
        if (job + stride >= P0_NOW) break;
        P0_STEP(Jb, vb_, job + 3 * stride);
        if (job + 2 * stride >= P0_NOW) break;
        job += 2 * stride;
    }
#undef P0_STEP
}

typedef short bf16x8t __attribute__((ext_vector_type(8)));
template <int CTRL> __device__ __forceinline__ float dppz(float v) { return __builtin_bit_cast(float, __builtin_amdgcn_update_dpp(0, __builtin_bit_cast(int, v), CTRL, 0xF, 0xF, true)); }
template <int CTRL> __device__ __forceinline__ float dpps(float v) { return __builtin_bit_cast(float, __builtin_amdgcn_update_dpp(__builtin_bit_cast(int, v), __builtin_bit_cast(int, v), CTRL, 0xF, 0xF, false)); }
__device__ __forceinline__ float rdl(float v, int l) { return __builtin_bit_cast(float, __builtin_amdgcn_readlane(__builtin_bit_cast(int, v), l)); }
__device__ __forceinline__ float wave_max(float v) {
    v = fmaxf(v, dpps<0xB1>(v)); v = fmaxf(v, dpps<0x4E>(v)); v = fmaxf(v, dpps<0x141>(v)); v = fmaxf(v, dpps<0x140>(v));
    return fmaxf(fmaxf(rdl(v, 0), rdl(v, 16)), fmaxf(rdl(v, 32), rdl(v, 48)));
}
__device__ __forceinline__ float scan_add_up(float x, int lane) {
    x += dppz<0x111>(x); x += dppz<0x112>(x); x += dppz<0x114>(x); x += dppz<0x118>(x);
    const float t0 = rdl(x, 15), t1 = rdl(x, 31), t2 = rdl(x, 47); const int row = lane >> 4;
    return x + ((row >= 1 ? t0 : 0.f) + (row >= 2 ? t1 : 0.f) + (row >= 3 ? t2 : 0.f));
}
__device__ __forceinline__ float scan_add_down(float x, int lane) {
    x += dppz<0x101>(x); x += dppz<0x102>(x); x += dppz<0x104>(x); x += dppz<0x108>(x);
    const float t1 = rdl(x, 16), t2 = rdl(x, 32), t3 = rdl(x, 48); const int row = lane >> 4;
    return x + ((row <= 2 ? t3 : 0.f) + (row <= 1 ? t2 : 0.f) + (row <= 0 ? t1 : 0.f));
}
__device__ __forceinline__ float scan_max_up(float x, int lane) {
    x = fmaxf(x, dpps<0x111>(x)); x = fmaxf(x, dpps<0x112>(x)); x = fmaxf(x, dpps<0x114>(x)); x = fmaxf(x, dpps<0x118>(x));
    const float t0 = rdl(x, 15), t1 = rdl(x, 31), t2 = rdl(x, 47); const int row = lane >> 4;
    const float c1 = t0, c2 = fmaxf(t0, t1), c3 = fmaxf(c2, t2);
    return row == 0 ? x : fmaxf(x, row == 1 ? c1 : (row == 2 ? c2 : c3));
}
__device__ __forceinline__ float scan_max_down(float x, int lane) {
    x = fmaxf(x, dpps<0x101>(x)); x = fmaxf(x, dpps<0x102>(x)); x = fmaxf(x, dpps<0x104>(x)); x = fmaxf(x, dpps<0x108>(x));
    const float t1 = rdl(x, 16), t2 = rdl(x, 32), t3 = rdl(x, 48); const int row = lane >> 4;
    const float c2 = t3, c1 = fmaxf(t3, t2), c0 = fmaxf(c1, t1);
    return row == 3 ? x : fmaxf(x, row == 2 ? c2 : (row == 1 ? c1 : c0));
}
__device__ __forceinline__ gm::f32x4 mma_lds(const LAS bf16* A, int lda, int m0, const LAS bf16* Bt, int ldb, int n0, int k0, gm::f32x4 acc, int fr, int fq) {
    const bf16x8t a = *(const LAS bf16x8t*)(A + (m0 + fr) * lda + k0 + 8 * fq), b = *(const LAS bf16x8t*)(Bt + (n0 + fr) * ldb + k0 + 8 * fq);
    return __builtin_amdgcn_mfma_f32_16x16x32_bf16(a, b, acc, 0, 0, 0);
}
template <bool SA, bool SB> __device__ __forceinline__ gm::f32x4 mma_lds_sw(const LAS bf16* A, int lda, int m0, const LAS bf16* Bt, int ldb, int n0, int k0, gm::f32x4 acc, int fr, int fq) {
    const int g = (k0 >> 3) + fq, ga = SA ? (g ^ (((m0 + fr) >> 3) & 7)) : g, gb = SB ? (g ^ (((n0 + fr) >> 3) & 7)) : g;
    const bf16x8t a = *(const LAS bf16x8t*)(A + (m0 + fr) * lda + 8 * ga), b = *(const LAS bf16x8t*)(Bt + (n0 + fr) * ldb + 8 * gb);
    return __builtin_amdgcn_mfma_f32_16x16x32_bf16(a, b, acc, 0, 0, 0);
}
constexpr int LP = 72;
template <int NP, bool SCALED> __device__ __forceinline__ void stage_T(LAS bf16* T, const bf16* g, int ld, int tid, const LAS float* rs0, LAS bf16* T1, const LAS float* rs1) {
    const int s = tid >> 3, part = tid & 7;
#pragma unroll
    for (int it = 0; it < NP / 8; ++it) {
        const u32x4t w = *(const u32x4t*)(g + (size_t)s * ld + (it * 8 + part) * 8); const int c0 = (it * 8 + part) * 8;
        const unsigned ww[4] = {w.x, w.y, w.z, w.w};
#pragma unroll
        for (int q = 0; q < 4; ++q) {
            const float lo = u2f(ww[q] << 16), hi = u2f(ww[q] & 0xFFFF0000u);
            if (SCALED) { const float f0 = rs0[s]; T[(c0 + 2 * q) * LP + s] = f2bf(lo * f0); T[(c0 + 2 * q + 1) * LP + s] = f2bf(hi * f0);
                const float f1 = rs1[s]; T1[(c0 + 2 * q) * LP + s] = f2bf(lo * f1); T1[(c0 + 2 * q + 1) * LP + s] = f2bf(hi * f1); }
            else { T[(c0 + 2 * q) * LP + s] = (bf16)(ww[q] & 0xFFFFu); T[(c0 + 2 * q + 1) * LP + s] = (bf16)(ww[q] >> 16); }
        }
    }
}
template <int R> __device__ __forceinline__ void stage_N(LAS bf16* T, const bf16* g, int ld, int tid) {
#pragma unroll
    for (int it = 0; it < R / 64; ++it) { const int idx = it * 512 + tid, rw = idx >> 3, part = idx & 7;
        *(LAS u32x4t*)(T + rw * LP + part * 8) = *(const u32x4t*)(g + (size_t)rw * ld + part * 8); }
}

__device__ __forceinline__ int swz_tok(int c0, int s) { return (((s >> 3) ^ ((c0 >> 3) & 7)) << 3) + (s & 7); }
__device__ __forceinline__ void putT(LAS bf16* T, const u32x4t w, int c0, int s) {
    const unsigned ww[4] = {w.x, w.y, w.z, w.w}; const int sw = swz_tok(c0, s);
#pragma unroll
    for (int q = 0; q < 4; ++q) { T[(c0 + 2 * q) * LP + sw] = (bf16)(ww[q] & 0xFFFFu); T[(c0 + 2 * q + 1) * LP + sw] = (bf16)(ww[q] >> 16); }
}
__device__ __forceinline__ void putT2(LAS bf16* T0, LAS bf16* T1, const u32x4t w, int c0, int s, float f0, float f1) {
    const unsigned ww[4] = {w.x, w.y, w.z, w.w}; const int sw = swz_tok(c0, s);
#pragma unroll
    for (int q = 0; q < 4; ++q) { const float lo = u2f(ww[q] << 16), hi = u2f(ww[q] & 0xFFFF0000u);
        T0[(c0 + 2 * q) * LP + sw] = f2bf(lo * f0); T0[(c0 + 2 * q + 1) * LP + sw] = f2bf(hi * f0); T1[(c0 + 2 * q) * LP + sw] = f2bf(lo * f1); T1[(c0 + 2 * q + 1) * LP + sw] = f2bf(hi * f1); }
}
__device__ __forceinline__ void o_m1(const Params& p, LAS unsigned char* lds) {
    int tid_ = threadIdx.x; asm volatile("" : "+v"(tid_));
    const int tid = tid_, wid = __builtin_amdgcn_readfirstlane(tid >> 6), lane = tid & 63, fr = lane & 15, fq = lane >> 4;
    constexpr int SETB = (2 * 64 + 128) * LP;
    const bf16* Kb = WSP(bf16, WS_K); const bf16* V = WSP(bf16, WS_V); const float* GT = WSP(float, WS_GT);
    bf16* DC = WSP(bf16, WS_BIG2); float* ND = WSP(float, WS_ND); float* SC = WSP(float, WS_SC);
    const int srow = tid >> 3, part = tid & 7, NU = NB * NH * NCH, G = (int)gridDim.x;
    u32x4t rk, rv0, rv1; float g0, g1, g2, g3;
#define M1_LOAD(u_) do { const int b_ = (u_) / (NH * NCH), h_ = ((u_) / NCH) % NH, c_ = (u_) % NCH; const size_t r_ = (size_t)b_ * S + c_ * 64 + srow; \
        rk = *(const u32x4t*)(Kb + r_ * QKW + h_ * DQK + part * 8); rv0 = *(const u32x4t*)(V + r_ * VW + h_ * DV + part * 8); rv1 = *(const u32x4t*)(V + r_ * VW + h_ * DV + 64 + part * 8); \
        const float* g_ = GT + ((size_t)b_ * S + c_ * 64 + lane) * 32 + h_; g0 = g_[0]; g1 = g_[8]; g2 = g_[16]; g3 = g_[24]; } while (0)
#define M1_STAGE(u_, s_) do { const int b_ = (u_) / (NH * NCH), h_ = ((u_) / NCH) % NH, c_ = (u_) % NCH; \
        LAS bf16* KTf_ = (LAS bf16*)lds + (s_) * SETB; LAS bf16* KTb_ = KTf_ + 64 * LP; LAS bf16* VT_ = KTb_ + 64 * LP; \
        const float bcf = scan_add_up(g1, lane), bcb = scan_add_down(g3, lane); \
        const float BLf = rdl(bcf, 63), BLb = rdl(bcb, 0); \
        const float rawf = BLf - bcf + g0, rawb = BLb - bcb + g2; \
        const float mlf = wave_max(rawf), mlb = wave_max(rawb); \
        const float wf_ = expf(rawf - mlf), wb_ = expf(rawb - mlb);                            \
        const float f0_ = __shfl(wf_, srow), f1_ = __shfl(wb_, srow);                            \
        if (tid == 0) { float* s0 = SC + ((size_t)((0 * NB + b_) * NH + h_) * NCH + c_) * 2; s0[0] = BLf; s0[1] = mlf; \
            float* s1 = SC + ((size_t)((1 * NB + b_) * NH + h_) * NCH + c_) * 2; s1[0] = BLb; s1[1] = mlb; } \
        putT(VT_, rv0, part * 8, srow); putT(VT_, rv1, 64 + part * 8, srow); putT2(KTf_, KTb_, rk, part * 8, srow, f0_, f1_); } while (0)
    int unit = blockIdx.x, set = 0;
    if (unit >= NU) return;
    M1_LOAD(unit); M1_STAGE(unit, 0);
    if (unit + G < NU) M1_LOAD(unit + G);
    __syncthreads();
    for (; unit < NU; unit += G, set ^= 1) {
        const int b = unit / (NH * NCH), h = (unit / NCH) % NH, c = unit % NCH;
        if (unit + G < NU) { M1_STAGE(unit + G, set ^ 1); if (unit + 2 * G < NU) M1_LOAD(unit + 2 * G); }
        const LAS bf16* KTf = (const LAS bf16*)lds + set * SETB; const LAS bf16* KTb = KTf + 64 * LP; const LAS bf16* VT = KTb + 64 * LP;
        {
            const int d = tid >> 8, dk = (tid >> 2) & 63, qt = tid & 3; const LAS bf16* kt = (d ? KTb : KTf) + dk * LP + qt * 16;
            f32x4t a0, a1, a2, a3; unpack8(*(const LAS u32x4t*)kt, a0, a1); unpack8(*(const LAS u32x4t*)(kt + 8), a2, a3);
            const f32x4t t4 = (a0 + a1) + (a2 + a3); float sum = (t4[0] + t4[1]) + (t4[2] + t4[3]);
            sum += dppz<0xB1>(sum); sum += dppz<0x4E>(sum);
            if (qt == 0) ND[((size_t)((d * NB + b) * NH + h) * NCH + c) * DQK + dk] = sum; }
        {
            const int d = wid >> 2, mt = wid & 3; const LAS bf16* A = d ? KTb : KTf;
            bf16* dst = DC + ((size_t)((d * NB + b) * NH + h) * NCH + c) * (DV * DQK);
#pragma unroll
            for (int nt = 0; nt < 8; ++nt) {
                gm::f32x4 acc = {0.f, 0.f, 0.f, 0.f};
                acc = mma_lds_sw<true, true>(A, LP, 16 * mt, VT, LP, 16 * nt, 0, acc, fr, fq); acc = mma_lds_sw<true, true>(A, LP, 16 * mt, VT, LP, 16 * nt, 32, acc, fr, fq);
                *(u32x2t*)(dst + (16 * nt + fr) * DQK + 16 * mt + 4 * fq) = pack4(acc);
            }
        }
        __syncthreads();
    }
#undef M1_LOAD
#undef M1_STAGE
}
__device__ __forceinline__ int chunk_of_order(int d, int o) { return d == 0 ? o : (o < CTX / 64 ? CTX / 64 - 1 - o : NCH - 1 - (o - CTX / 64)); }
__device__ __forceinline__ void o_m2(const Params& p) {
    int tid_ = threadIdx.x; asm volatile("" : "+v"(tid_));
    for (int gt = blockIdx.x * 512 + tid_; gt < 2 * NB * NH * 1024; gt += gridDim.x * 512) {
    const int chain = gt >> 10, e8 = gt & 1023, d = chain / (NB * NH);
    bf16* DC = WSP(bf16, WS_BIG2) + (size_t)chain * NCH * (DV * DQK) + e8 * 8; float* ND = WSP(float, WS_ND) + (size_t)chain * NCH * DQK; const float* SC = WSP(float, WS_SC) + (size_t)chain * NCH * 2; float* MS = WSP(float, WS_MS) + (size_t)chain * NCH;
    float m = 0.f, acc[8], nacc[8];
#pragma unroll
    for (int q = 0; q < 8; ++q) { acc[q] = 0.f; nacc[q] = 0.f; }
    constexpr int PD = 4; static_assert(NCH % PD == 0, "");
    u32x4t wq[PD]; f32x4t aq0[PD], aq1[PD]; float blq[PD], mlq[PD];
#define M2_LOAD(k_, o_) do { const int c_ = chunk_of_order(d, (o_)); wq[k_] = *(const u32x4t*)(DC + (size_t)c_ * (DV * DQK)); blq[k_] = SC[c_ * 2]; mlq[k_] = SC[c_ * 2 + 1]; \
        if (e8 < 8) { const float* np_ = ND + c_ * DQK + e8 * 8; aq0[k_] = *(const f32x4t*)np_; aq1[k_] = *(const f32x4t*)(np_ + 4); } } while (0)
#pragma unroll
    for (int k = 0; k < PD; ++k) { aq0[k] = (f32x4t){0.f, 0.f, 0.f, 0.f}; aq1[k] = aq0[k]; M2_LOAD(k, k); }
    for (int o4 = 0; o4 < NCH; o4 += PD) {
#pragma unroll
        for (int k = 0; k < PD; ++k) {
            const int o = o4 + k, c = chunk_of_order(d, o);
            const float BL = blq[k], ml = mlq[k], mn = fmaxf(BL + m, ml), dec = expf(BL + m - mn), sc = expf(ml - mn);
            bf16* ptr = DC + (size_t)c * (DV * DQK);
            const u32x4t w = wq[k]; const unsigned ww[4] = {w.x, w.y, w.z, w.w}; const f32x4t a0 = aq0[k], a1 = aq1[k];
            u32x4t st; st.x = gm::cvt_pk_bf16(acc[0], acc[1]); st.y = gm::cvt_pk_bf16(acc[2], acc[3]); st.z = gm::cvt_pk_bf16(acc[4], acc[5]); st.w = gm::cvt_pk_bf16(acc[6], acc[7]);
            *(u32x4t*)ptr = st;
            if (e8 < 8) { float* np_ = ND + c * DQK + e8 * 8;
                *(f32x4t*)np_ = (f32x4t){nacc[0], nacc[1], nacc[2], nacc[3]}; *(f32x4t*)(np_ + 4) = (f32x4t){nacc[4], nacc[5], nacc[6], nacc[7]};
                if (e8 == 0) MS[c] = m; }
            if (o + PD < NCH) M2_LOAD(k, o + PD);
#pragma unroll
            for (int q = 0; q < 4; ++q) { acc[2 * q] = dec * acc[2 * q] + sc * u2f(ww[q] << 16); acc[2 * q + 1] = dec * acc[2 * q + 1] + sc * u2f(ww[q] & 0xFFFF0000u); }
#pragma unroll
            for (int q = 0; q < 4; ++q) { nacc[q] = dec * nacc[q] + sc * a0[q]; nacc[4 + q] = dec * nacc[4 + q] + sc * a1[q]; }
            m = mn;
        }
    }
#undef M2_LOAD
    }
}
__device__ __forceinline__ void o_m3(const Params& p, const int i, LAS unsigned char* lds) {
    int tid_ = threadIdx.x; asm volatile("" : "+v"(tid_));
    const int tid = tid_, wid = __builtin_amdgcn_readfirstlane(tid >> 6), lane = tid & 63, fr = lane & 15, fq = lane >> 4, j = i >> 1;
    LAS bf16* QS = (LAS bf16*)lds; LAS bf16* KS = QS + 64 * LP; LAS bf16* VT = KS + 64 * LP; LAS bf16* CF = VT + 128 * LP; LAS bf16* CB = CF + 128 * LP; LAS bf16* SWF = CB + 128 * LP; LAS bf16* SWB = SWF + 64 * LP;
    LAS float* HS = (LAS float*)(SWB + 64 * LP); constexpr int HP = 132;
    const LAS float* WF_DUMMY = (const LAS float*)lds;
    LAS float* SM = HS + 64 * HP;
    const bf16* Q = WSP(bf16, WS_Q); const bf16* Kb = WSP(bf16, WS_K); const bf16* V = WSP(bf16, WS_V); const bf16* O = WSP(bf16, WS_O); const float* GT = WSP(float, WS_GT);
    const bf16* DC = WSP(bf16, WS_BIG2); const float* ND = WSP(float, WS_ND); const float* MS = WSP(float, WS_MS); bf16* RB = WSP(bf16, WS_RB);
    const int srow = tid >> 3, part = tid & 7;
    u32x4t rq, rk, rv0, rv1, rcf0, rcf1, rcb0, rcb1, ro0, ro1; float g0 = 0.f, g1 = 0.f, g2 = 0.f, g3 = 0.f, gms0 = 0.f, gms1 = 0.f, gnd0 = 0.f, gnd1 = 0.f;
#define M3_LOAD(u_) do { const int b_ = (u_) / (NH * NCH), h_ = ((u_) / NCH) % NH, c_ = (u_) % NCH; const size_t r_ = (size_t)b_ * S + c_ * 64 + srow; \
        const size_t c0_ = (size_t)((0 * NB + b_) * NH + h_) * NCH + c_, c1_ = (size_t)((1 * NB + b_) * NH + h_) * NCH + c_; \
        rq = *(const u32x4t*)(Q + r_ * QKW + h_ * DQK + part * 8); rk = *(const u32x4t*)(Kb + r_ * QKW + h_ * DQK + part * 8); \
        rv0 = *(const u32x4t*)(V + r_ * VW + h_ * DV + part * 8); rv1 = *(const u32x4t*)(V + r_ * VW + h_ * DV + 64 + part * 8); \
        ro0 = *(const u32x4t*)(O + r_ * VW + h_ * DV + part * 16); ro1 = *(const u32x4t*)(O + r_ * VW + h_ * DV + part * 16 + 8); \
        rcf0 = *(const u32x4t*)(DC + c0_ * (DV * DQK) + (size_t)srow * DQK + part * 8); rcf1 = *(const u32x4t*)(DC + c0_ * (DV * DQK) + (size_t)(64 + srow) * DQK + part * 8); \
        rcb0 = *(const u32x4t*)(DC + c1_ * (DV * DQK) + (size_t)srow * DQK + part * 8); rcb1 = *(const u32x4t*)(DC + c1_ * (DV * DQK) + (size_t)(64 + srow) * DQK + part * 8); \
        if (wid == 0) { const float* g_ = GT + ((size_t)b_ * S + c_ * 64 + lane) * 32 + h_; g0 = g_[0]; g1 = g_[8]; g2 = g_[16]; g3 = g_[24]; gms0 = MS[c0_]; gms1 = MS[c1_]; gnd0 = ND[c0_ * DQK + lane]; gnd1 = ND[c1_ * DQK + lane]; } } while (0)
    int unit = blockIdx.x;
    if (unit < NB * NH * NCH) M3_LOAD(unit);
    for (; unit < NB * NH * NCH; unit += gridDim.x) {
        const int b = unit / (NH * NCH), h = (unit / NCH) % NH, c = unit % NCH; const size_t r0 = (size_t)b * S + c * 64;
        if (wid == 0) {
            const float gif = g0, lff = g1, gib = g2, lfb = g3;
            const float bcf = scan_add_up(lff, lane), bcb = scan_add_down(lfb, lane);
            const float af = gif - bcf, ab = gib - bcb;
            const float mpf = gms0, mpb = gms1;
            const float mxf = fmaxf(mpf, scan_max_up(af, lane)), mxb = fmaxf(mpb, scan_max_down(ab, lane));
            SM[lane] = af; SM[64 + lane] = -mxf; SM[128 + lane] = expf(mpf - mxf); SM[192 + lane] = expf(-(bcf + mxf)); SM[320 + lane] = gnd0;
            SM[384 + lane] = ab; SM[384 + 64 + lane] = -mxb; SM[384 + 128 + lane] = expf(mpb - mxb); SM[384 + 192 + lane] = expf(-(bcb + mxb)); SM[384 + 320 + lane] = gnd1;
        }
        *(LAS u32x4t*)(QS + srow * LP + part * 8) = rq; *(LAS u32x4t*)(KS + srow * LP + part * 8) = rk;
        putT(VT, rv0, part * 8, srow); putT(VT, rv1, 64 + part * 8, srow);
        *(LAS u32x4t*)(CF + srow * LP + part * 8) = rcf0; *(LAS u32x4t*)(CF + (64 + srow) * LP + part * 8) = rcf1;
        *(LAS u32x4t*)(CB + srow * LP + part * 8) = rcb0; *(LAS u32x4t*)(CB + (64 + srow) * LP + part * 8) = rcb1;
        __syncthreads();
        const u32x4t co0 = ro0, co1 = ro1;
        if (unit + (int)gridDim.x < NB * NH * NCH) M3_LOAD(unit + (int)gridDim.x);
        {
            const int mt = wid & 3;
#pragma unroll
            for (int q = 0; q < 2; ++q) { const int nt = (wid >> 2) * 2 + q;
                gm::f32x4 acc = {0.f, 0.f, 0.f, 0.f};
                acc = mma_lds(QS, LP, 16 * mt, KS, LP, 16 * nt, 0, acc, fr, fq); acc = mma_lds(QS, LP, 16 * mt, KS, LP, 16 * nt, 32, acc, fr, fq);
                const int s = 16 * nt + fr; const float afs = SM[s], abs_ = SM[384 + s];
#pragma unroll
                for (int jj = 0; jj < 4; ++jj) { const int jr = 16 * mt + 4 * fq + jj;
                    const float wf = (s <= jr) ? __expf(SM[64 + jr] + afs) : 0.f, wb = (s >= jr) ? __expf(SM[384 + 64 + jr] + abs_) : 0.f;
                    SWF[jr * LP + s] = f2bf(acc[jj] * wf); SWB[jr * LP + s] = f2bf(acc[jj] * wb); }
            }
        }
        __syncthreads();
        {
            const int d = tid >> 8, jr = (tid >> 2) & 63, sg = (tid & 3) * 16; const LAS bf16* sw = (d ? SWB : SWF) + jr * LP + sg; const LAS float* sm = SM + d * 384; float rs = 0.f, qn = 0.f;
#pragma unroll
            for (int s = 0; s < 16; ++s) { rs += bf2f(sw[s]); qn += bf2f(QS[jr * LP + sg + s]) * sm[320 + sg + s]; }
            rs += __shfl_xor(rs, 1); qn += __shfl_xor(qn, 1); rs += __shfl_xor(rs, 2); qn += __shfl_xor(qn, 2);
            const float den = rs + sm[128 + jr] * qn;
            if ((tid & 3) == 0) SM[d * 384 + 256 + jr] = 1.0f / fmaxf(fabsf(den), sm[192 + jr]); }
        gm::f32x4 a1f[4], a2f[4], a1b[4], a2b[4];
        f32x4t cg0, cg1, cg2, cg3;
        { const float* gh_ = p.m_g_head + j * VW + h * DV + part * 16; cg0 = *(const f32x4t*)gh_; cg1 = *(const f32x4t*)(gh_ + 4); cg2 = *(const f32x4t*)(gh_ + 8); cg3 = *(const f32x4t*)(gh_ + 12); }
        {
            const int mt = wid & 3, ntb = (wid >> 2) * 4;
#pragma unroll
            for (int q = 0; q < 4; ++q) { const int n0 = 16 * (ntb + q);
                gm::f32x4 z = {0.f, 0.f, 0.f, 0.f};
                a1f[q] = mma_lds_sw<false, true>(SWF, LP, 16 * mt, VT, LP, n0, 32, mma_lds_sw<false, true>(SWF, LP, 16 * mt, VT, LP, n0, 0, z, fr, fq), fr, fq);
                a2f[q] = mma_lds(QS, LP, 16 * mt, CF, LP, n0, 32, mma_lds(QS, LP, 16 * mt, CF, LP, n0, 0, z, fr, fq), fr, fq);
                a1b[q] = mma_lds_sw<false, true>(SWB, LP, 16 * mt, VT, LP, n0, 32, mma_lds_sw<false, true>(SWB, LP, 16 * mt, VT, LP, n0, 0, z, fr, fq), fr, fq);
                a2b[q] = mma_lds(QS, LP, 16 * mt, CB, LP, n0, 32, mma_lds(QS, LP, 16 * mt, CB, LP, n0, 0, z, fr, fq), fr, fq);
            }
        }
        __syncthreads();
        {
            const int mt = wid & 3, ntb = (wid >> 2) * 4;
#pragma unroll
            for (int jj = 0; jj < 4; ++jj) { const int jr = 16 * mt + 4 * fq + jj;
                const float wif = SM[128 + jr], ivf = SM[256 + jr], wib = SM[384 + 128 + jr], ivb = SM[384 + 256 + jr];
#pragma unroll
                for (int q = 0; q < 4; ++q) HS[jr * HP + 16 * (ntb + q) + fr] = (a1f[q][jj] + wif * a2f[q][jj]) * ivf + (a1b[q][jj] + wib * a2b[q][jj]) * ivb;
            }
        }
        __syncthreads();
        {
            const int row = tid >> 3, seg = tid & 7; const LAS float* hp = HS + row * HP + seg * 16;
            f32x4t hv[4]; float ss = 0.f;
#pragma unroll
            for (int q = 0; q < 4; ++q) { hv[q] = *(const LAS f32x4t*)(hp + 4 * q); ss += hv[q][0] * hv[q][0] + hv[q][1] * hv[q][1] + hv[q][2] * hv[q][2] + hv[q][3] * hv[q][3]; }
            ss += __shfl_xor(ss, 1); ss += __shfl_xor(ss, 2); ss += __shfl_xor(ss, 4);
            const float rs = 1.0f / sqrtf(ss * (1.0f / (float)DV) + EPS);
            const int col = h * DV + seg * 16; const size_t r = r0 + row;
            {   const f32x4t o0 = unpack4((u32x2t){co0.x, co0.y}), o1 = unpack4((u32x2t){co0.z, co0.w}), o2 = unpack4((u32x2t){co1.x, co1.y}), o3 = unpack4((u32x2t){co1.z, co1.w});
                const u32x2t w0 = pack4(hv[0] * rs * cg0 * o0), w1 = pack4(hv[1] * rs * cg1 * o1), w2 = pack4(hv[2] * rs * cg2 * o2), w3 = pack4(hv[3] * rs * cg3 * o3);
                *(u32x4t*)(RB + r * RBK + col) = (u32x4t){w0.x, w0.y, w1.x, w1.y}; *(u32x4t*)(RB + r * RBK + col + 8) = (u32x4t){w2.x, w2.y, w3.x, w3.y}; }
        }
        __syncthreads();
    }
}

constexpr int XP = 136;
__device__ __forceinline__ float neg_expm1(float x) {
    return x > -0.125f ? -x * (1.0f + x * (0.5f + x * (0.16666667f + x * (0.041666668f + x * 0.0083333338f)))) : 1.0f - __expf(x);
}
__device__ __forceinline__ bf16* rg_arr(const Params& p, int which) { return which < 2 ? WSP(bf16, WS_BIG2) + (size_t)which * (MROWS * D + SKEW / 2) : WSP(bf16, WS_XC); }
__device__ __forceinline__ void o_rg1(const Params& p, const int i, LAS unsigned char* lds) {
    int tid_ = threadIdx.x; asm volatile("" : "+v"(tid_));
    const int tid = tid_, wid = __builtin_amdgcn_readfirstlane(tid >> 6), lane = tid & 63, fr = lane & 15, fq = lane >> 4, j = i >> 1;
    const int nblk = blockIdx.x & 7, jc = wid * 16 + fr, ch = nblk * RBW + jc;
    LAS bf16* XC = (LAS bf16*)lds; LAS float* CW = (LAS float*)(lds + 17408);
    const bf16* XR = WSP(bf16, WS_XR); float* RSUM = WSP(float, WS_RSUM);
    for (int it = tid; it < 5 * RBW; it += 512) { const int t = it / RBW, c2 = it % RBW; CW[it] = t < 4 ? p.r_conv_w[(j * 4 + t) * D + nblk * RBW + c2] : p.r_conv_b[j * D + nblk * RBW + c2]; }
    bf16x8t Br[2][4], Bi[2][4]; float sp8[2], sp8l[2], nbr[2], nbi[2];
#pragma unroll
    for (int d = 0; d < 2; ++d) {
        const bf16* wg = WSP(bf16, WS_WG) + ((size_t)(j * 2 + d) * 8 + nblk) * 2 * RBW * RBW;
#pragma unroll
        for (int ks = 0; ks < 4; ++ks) { Br[d][ks] = *(const bf16x8t*)(wg + (size_t)jc * RBW + ks * 32 + 8 * fq); Bi[d][ks] = *(const bf16x8t*)(wg + (size_t)(RBW + jc) * RBW + ks * 32 + 8 * fq); }
        sp8[d] = 8.0f * softplusf_(-p.r_lam[(j * 2 + d) * D + ch]);
        const float* bg = p.r_b_gate + ((size_t)(j * 2 + d) * 8 + nblk) * 2 * RBW; nbr[d] = -1.4426950408889634f * bg[jc]; nbi[d] = -1.4426950408889634f * bg[RBW + jc]; sp8l[d] = 1.4426950408889634f * sp8[d];
    }
    __syncthreads();
    for (int k = 0; k < (NB * NCH + 31) / 32; ++k) {
        const int bc = k * 32 + (blockIdx.x >> 3); if (bc >= NB * NCH) break;
        const int b = bc / NCH, c = bc % NCH;
        const int seg_lo = c < CTX / 64 ? 0 : CTX, seg_hi = c < CTX / 64 ? CTX : S;
        {
            const int token = tid >> 3, cg = tid & 7, s = c * 64 + token;
            f32x4t y[4];
#pragma unroll
            for (int q = 0; q < 4; ++q) y[q] = *(const LAS f32x4t*)(CW + 4 * RBW + cg * 16 + 4 * q);
#pragma unroll
            for (int t = 0; t < 4; ++t) { const int ss = s + t - 2;
                if (ss >= seg_lo && ss < seg_hi) { const bf16* src = XR + ((size_t)b * S + ss) * D + nblk * RBW + cg * 16;
                    const u32x4t w0 = *(const u32x4t*)src, w1 = *(const u32x4t*)(src + 8);
                    const f32x4t x0 = unpack4((u32x2t){w0.x, w0.y}), x1 = unpack4((u32x2t){w0.z, w0.w}), x2 = unpack4((u32x2t){w1.x, w1.y}), x3 = unpack4((u32x2t){w1.z, w1.w});
                    const LAS float* cw = CW + t * RBW + cg * 16;
                    y[0] += *(const LAS f32x4t*)(cw) * x0; y[1] += *(const LAS f32x4t*)(cw + 4) * x1; y[2] += *(const LAS f32x4t*)(cw + 8) * x2; y[3] += *(const LAS f32x4t*)(cw + 12) * x3; } }
            const u32x2t p0 = pack4(y[0]), p1 = pack4(y[1]), p2 = pack4(y[2]), p3 = pack4(y[3]);
            *(LAS u32x4t*)(XC + token * XP + cg * 16) = (u32x4t){p0.x, p0.y, p1.x, p1.y}; *(LAS u32x4t*)(XC + token * XP + cg * 16 + 8) = (u32x4t){p2.x, p2.y, p3.x, p3.y};
        }
        __syncthreads();
        const size_t aoff = ((((size_t)bc * 8 + nblk) * 8 + wid) * 64 + lane) * 16;
        float hl[16];
#pragma unroll
        for (int d = 0; d < 2; ++d) {
            gm::f32x4 ar[4], ai[4];
#pragma unroll
            for (int mt = 0; mt < 4; ++mt) { ar[mt] = (gm::f32x4){0.f, 0.f, 0.f, 0.f}; ai[mt] = (gm::f32x4){0.f, 0.f, 0.f, 0.f}; }
#pragma unroll
            for (int ks = 0; ks < 4; ++ks)
#pragma unroll
                for (int mt = 0; mt < 4; ++mt) {
                    const bf16x8t a = *(const LAS bf16x8t*)(XC + ((fr >> 2) * 16 + mt * 4 + (fr & 3)) * XP + ks * 32 + 8 * fq);
                    ar[mt] = __builtin_amdgcn_mfma_f32_16x16x32_bf16(a, Br[d][ks], ar[mt], 0, 0, 0); ai[mt] = __builtin_amdgcn_mfma_f32_16x16x32_bf16(a, Bi[d][ks], ai[mt], 0, 0, 0);
                }
            float av[16], bx[16];
#pragma unroll
            for (int q = 0; q < 16; ++q) {
                const float sr = __builtin_amdgcn_rcpf(1.0f + __builtin_amdgcn_exp2f(fmaf(ar[q >> 2][q & 3], -1.4426950408889634f, nbr[d]))), si = __builtin_amdgcn_rcpf(1.0f + __builtin_amdgcn_exp2f(fmaf(ai[q >> 2][q & 3], -1.4426950408889634f, nbi[d])));
                const float a_ = __builtin_amdgcn_exp2f(-sp8l[d] * sr), x2 = -2.0f * sp8[d] * sr;
                const float om = x2 > -0.0625f ? -x2 * (1.0f + x2 * (0.5f + x2 * (0.16666667f + x2 * 0.041666668f))) : fmaf(-a_, a_, 1.0f);
                av[q] = a_; bx[q] = __builtin_amdgcn_sqrtf(om) * si * bf2f(XC[(16 * fq + q) * XP + jc]);
            }
            float P = 1.0f, H = 0.f;
#pragma unroll
            for (int o = 0; o < 16; ++o) { const int q = d ? 15 - o : o; H = av[q] * H + bx[q]; P *= av[q]; }
            float Pg[4], Hg[4];
#pragma unroll
            for (int g = 0; g < 4; ++g) { Pg[g] = __shfl(P, fr + 16 * g); Hg[g] = __shfl(H, fr + 16 * g); }
            float st = 0.f, pt = 1.0f, myc = 0.f, myp = 1.0f;
#pragma unroll
            for (int pg = 0; pg < 4; ++pg) { const int g = d ? 3 - pg : pg; if (g == fq) { myc = st; myp = pt; } st = Pg[g] * st + Hg[g]; pt *= Pg[g]; }
            const size_t sidx = ((size_t)(d * NB + b) * NCH + c) * D + ch;
            if (fq == 0) { RSUM[sidx * 2] = pt; RSUM[sidx * 2 + 1] = st; }
            float pc[16]; float hh = myc, pp = myp;
#pragma unroll
            for (int o = 0; o < 16; ++o) { const int q = d ? 15 - o : o; hh = av[q] * hh + bx[q]; pp *= av[q]; pc[q] = pp; if (d == 0) hl[q] = hh; else hl[q] += hh; }
            {
                u32x4t w0, w1; bf16* pp_ = rg_arr(p, 1 + d) + aoff;
                w0.x = gm::cvt_pk_bf16(pc[0], pc[1]); w0.y = gm::cvt_pk_bf16(pc[2], pc[3]); w0.z = gm::cvt_pk_bf16(pc[4], pc[5]); w0.w = gm::cvt_pk_bf16(pc[6], pc[7]);
                w1.x = gm::cvt_pk_bf16(pc[8], pc[9]); w1.y = gm::cvt_pk_bf16(pc[10], pc[11]); w1.z = gm::cvt_pk_bf16(pc[12], pc[13]); w1.w = gm::cvt_pk_bf16(pc[14], pc[15]);
                *(u32x4t*)pp_ = w0; *(u32x4t*)(pp_ + 8) = w1;
            }
        }
        {
            u32x4t w0, w1; bf16* hp_ = rg_arr(p, 0) + aoff;
            w0.x = gm::cvt_pk_bf16(hl[0], hl[1]); w0.y = gm::cvt_pk_bf16(hl[2], hl[3]); w0.z = gm::cvt_pk_bf16(hl[4], hl[5]); w0.w = gm::cvt_pk_bf16(hl[6], hl[7]);
            w1.x = gm::cvt_pk_bf16(hl[8], hl[9]); w1.y = gm::cvt_pk_bf16(hl[10], hl[11]); w1.z = gm::cvt_pk_bf16(hl[12], hl[13]); w1.w = gm::cvt_pk_bf16(hl[14], hl[15]);
            *(u32x4t*)hp_ = w0; *(u32x4t*)(hp_ + 8) = w1;
        }
        __syncthreads();
    }
}
__device__ __forceinline__ void o_rg3(const Params& p, const int i, LAS unsigned char* lds) {
    int tid_ = threadIdx.x; asm volatile("" : "+v"(tid_));
    const int tid = tid_, wid = __builtin_amdgcn_readfirstlane(tid >> 6), lane = tid & 63, fr = lane & 15, fq = lane >> 4;
    const int nblk = blockIdx.x & 7, jc = wid * 16 + fr, ch = nblk * RBW + jc;
    LAS float* HS = (LAS float*)lds; constexpr int HP = 132;
    const bf16* GY = WSP(bf16, WS_GY); bf16* RB = WSP(bf16, WS_RB); const float* CIN = WSP(float, WS_RCIN);
    for (int k = 0; k < (NB * NCH + 31) / 32; ++k) {
        const int bc = k * 32 + (blockIdx.x >> 3); if (bc >= NB * NCH) break;
        const int b = bc / NCH, c = bc % NCH;
        if (i == DEPTH - 1 && c < CTX / 64) continue;
        const size_t r0 = (size_t)b * S + c * 64;
        const size_t aoff = ((((size_t)bc * 8 + nblk) * 8 + wid) * 64 + lane) * 16;
        u32x4t w[3][2];
#pragma unroll
        for (int a3 = 0; a3 < 3; ++a3) { const bf16* ap = rg_arr(p, a3) + aoff; w[a3][0] = *(const u32x4t*)ap; w[a3][1] = *(const u32x4t*)(ap + 8); }
        const float cf = CIN[((size_t)(0 * NB + b) * NCH + c) * D + ch], cb = CIN[((size_t)(1 * NB + b) * NCH + c) * D + ch];
#pragma unroll
        for (int hlf = 0; hlf < 2; ++hlf) {
            const unsigned uh[4] = {w[0][hlf].x, w[0][hlf].y, w[0][hlf].z, w[0][hlf].w}, uf[4] = {w[1][hlf].x, w[1][hlf].y, w[1][hlf].z, w[1][hlf].w}, ub[4] = {w[2][hlf].x, w[2][hlf].y, w[2][hlf].z, w[2][hlf].w};
#pragma unroll
            for (int q2 = 0; q2 < 4; ++q2) { const int q = 8 * hlf + 2 * q2;
                HS[(16 * fq + q) * HP + jc] = u2f(uh[q2] << 16) + u2f(uf[q2] << 16) * cf + u2f(ub[q2] << 16) * cb;
                HS[(16 * fq + q + 1) * HP + jc] = u2f(uh[q2] & 0xFFFF0000u) + u2f(uf[q2] & 0xFFFF0000u) * cf + u2f(ub[q2] & 0xFFFF0000u) * cb; }
        }
        __syncthreads();
        {
            const int token = tid >> 3, cg = tid & 7; const size_t r = r0 + token;
            const bf16* gy = GY + r * D + nblk * RBW + cg * 16; const u32x4t g0 = *(const u32x4t*)gy, g1 = *(const u32x4t*)(gy + 8);
            const LAS float* hp = HS + token * HP + cg * 16;
            const u32x2t o0 = pack4(unpack4((u32x2t){g0.x, g0.y}) * *(const LAS f32x4t*)(hp)), o1 = pack4(unpack4((u32x2t){g0.z, g0.w}) * *(const LAS f32x4t*)(hp + 4)),
                         o2 = pack4(unpack4((u32x2t){g1.x, g1.y}) * *(const LAS f32x4t*)(hp + 8)), o3 = pack4(unpack4((u32x2t){g1.z, g1.w}) * *(const LAS f32x4t*)(hp + 12));
            bf16* dst = RB + r * RBK + nblk * RBW + cg * 16;
            *(u32x4t*)dst = (u32x4t){o0.x, o0.y, o1.x, o1.y}; *(u32x4t*)(dst + 8) = (u32x4t){o2.x, o2.y, o3.x, o3.y};
        }
        __syncthreads();
    }
}
__device__ __forceinline__ void o_rg2(const Params& p) {
    int tid_ = threadIdx.x; asm volatile("" : "+v"(tid_));
    const float* RSUM = WSP(float, WS_RSUM); float* CIN = WSP(float, WS_RCIN);
    if (tid_ >= 64) return;
    for (int gt = blockIdx.x * 64 + tid_; gt < 2 * NB * D; gt += gridDim.x * 64) {
        const int chn = gt % D, db = gt / D, d = db / NB; float carry = 0.f;
        f32x2 ph[NCH];
#pragma unroll
        for (int o = 0; o < NCH; ++o) { const int c = chunk_of_order(d, o); ph[o] = *(const f32x2*)(RSUM + (((size_t)db * NCH + c) * D + chn) * 2); }
#pragma unroll
        for (int o = 0; o < NCH; ++o) { const int c = chunk_of_order(d, o); CIN[((size_t)db * NCH + c) * D + chn] = carry; carry = ph[o][0] * carry + ph[o][1]; }
    }
}

__device__ __forceinline__ void n_m1x(const Params& p, size_t gtid, size_t nthr) {
    const bf16* Kb = WSP(bf16, WS_K); const bf16* V = WSP(bf16, WS_V); const float* GT = WSP(float, WS_GT);
    bf16* DC = WSP(bf16, WS_BIG2); float* ND = WSP(float, WS_ND); float* SC = WSP(float, WS_SC);
    for (size_t it = gtid; it < (size_t)2 * NB * NH * NCH * DV; it += nthr) {
        const int v = (int)(it % DV); const size_t ch = it / DV; const int c = (int)(ch % NCH), h = (int)((ch / NCH) % NH), b = (int)((ch / (NCH * NH)) % NB), d = (int)(ch / ((size_t)NCH * NH * NB));
        const size_t r0 = (size_t)b * S + c * 64;
        float BL = 0.f; for (int s = 0; s < 64; ++s) BL += GT[(r0 + s) * 32 + (2 * d + 1) * 8 + h];
        float bc = 0.f, ml = -3.0e38f;
        for (int o = 0; o < 64; ++o) { const int s = d == 0 ? o : 63 - o; bc += GT[(r0 + s) * 32 + (2 * d + 1) * 8 + h]; ml = fmaxf(ml, BL - bc + GT[(r0 + s) * 32 + (2 * d) * 8 + h]); }
        float acc[DQK], nn[DQK];
#pragma unroll
        for (int k = 0; k < DQK; ++k) { acc[k] = 0.f; nn[k] = 0.f; }
        bc = 0.f;
        for (int o = 0; o < 64; ++o) { const int s = d == 0 ? o : 63 - o; bc += GT[(r0 + s) * 32 + (2 * d + 1) * 8 + h];
            const float w = expf(BL - bc + GT[(r0 + s) * 32 + (2 * d) * 8 + h] - ml), vv = bf2f(V[(r0 + s) * VW + h * DV + v]);
#pragma unroll
            for (int k = 0; k < DQK; ++k) { const float kw = bf2f(f2bf(bf2f(Kb[(r0 + s) * QKW + h * DQK + k]) * w)); acc[k] += vv * kw; nn[k] += kw; } }
#pragma unroll
        for (int k = 0; k < DQK; ++k) DC[ch * (DV * DQK) + (size_t)v * DQK + k] = f2bf(acc[k]);
        if (v == 0) {
#pragma unroll
            for (int k = 0; k < DQK; ++k) ND[ch * DQK + k] = nn[k];
            SC[ch * 2] = BL; SC[ch * 2 + 1] = ml; }
    }
}
__device__ __forceinline__ void n_m3x(const Params& p, size_t gtid, size_t nthr) {
    const bf16* Q = WSP(bf16, WS_Q); const bf16* Kb = WSP(bf16, WS_K); const bf16* V = WSP(bf16, WS_V); const float* GT = WSP(float, WS_GT);
    const bf16* DC = WSP(bf16, WS_BIG2); const float* ND = WSP(float, WS_ND); const float* MS = WSP(float, WS_MS); bf16* HB = WSP(bf16, WS_HB);
    for (size_t it = gtid; it < (size_t)NB * NH * NCH * 64 * 8; it += nthr) {
        const int vg = (int)(it & 7), jr = (int)((it >> 3) & 63); const int unit = (int)(it >> 9); const int b = unit / (NH * NCH), h = (unit / NCH) % NH, c = unit % NCH; const size_t r0 = (size_t)b * S + c * 64;
        float out[16];
#pragma unroll
        for (int q = 0; q < 16; ++q) out[q] = 0.f;
        for (int d = 0; d < 2; ++d) {
            const size_t ch = (size_t)((d * NB + b) * NH + h) * NCH + c; const float mprev = MS[ch];
            float bc = 0.f, pm = -3.0e38f;
            for (int o = 0; o < 64; ++o) { const int s = d == 0 ? o : 63 - o; bc += GT[(r0 + s) * 32 + (2 * d + 1) * 8 + h]; pm = fmaxf(pm, GT[(r0 + s) * 32 + (2 * d) * 8 + h] - bc); if (s == jr) break; }
            const float bcj = bc, mx = fmaxf(mprev, pm), mpos = bcj + mx, wint = expf(mprev - mx);
            float num[16]; float den = 0.f;
#pragma unroll
            for (int q = 0; q < 16; ++q) num[q] = 0.f;
            bc = 0.f;
            for (int o = 0; o < 64; ++o) { const int s = d == 0 ? o : 63 - o; bc += GT[(r0 + s) * 32 + (2 * d + 1) * 8 + h];
                const float w = expf(GT[(r0 + s) * 32 + (2 * d) * 8 + h] - bc - mx);
                float sj = 0.f; for (int k = 0; k < DQK; ++k) sj += bf2f(Q[(r0 + jr) * QKW + h * DQK + k]) * bf2f(Kb[(r0 + s) * QKW + h * DQK + k]);
                const float sw = bf2f(f2bf(sj * w)); den += sw;
#pragma unroll
                for (int q = 0; q < 16; ++q) num[q] += sw * bf2f(V[(r0 + s) * VW + h * DV + vg * 16 + q]);
                if (s == jr) break; }
            float qn = 0.f; float qc[16];
#pragma unroll
            for (int q = 0; q < 16; ++q) qc[q] = 0.f;
            for (int k = 0; k < DQK; ++k) { const float qq = bf2f(Q[(r0 + jr) * QKW + h * DQK + k]); qn += qq * ND[ch * DQK + k];
#pragma unroll
                for (int q = 0; q < 16; ++q) qc[q] += qq * bf2f(DC[ch * (DV * DQK) + (size_t)(vg * 16 + q) * DQK + k]); }
            const float dn = den + wint * qn, inv = 1.0f / fmaxf(fabsf(dn), expf(-mpos));
#pragma unroll
            for (int q = 0; q < 16; ++q) out[q] += (num[q] + wint * qc[q]) * inv;
        }
#pragma unroll
        for (int q = 0; q < 16; ++q) HB[(r0 + jr) * D + h * DV + vg * 16 + q] = f2bf(out[q]);
    }
}
__device__ __forceinline__ void n_m3y(const Params& p, int i, size_t gtid, size_t nthr) {
    const bf16* HB = WSP(bf16, WS_HB); const bf16* O = WSP(bf16, WS_O); bf16* RB = WSP(bf16, WS_RB); const int j = i >> 1;
    for (size_t it = gtid; it < (size_t)MROWS * NH; it += nthr) {
        const size_t r = it / NH; const int h = (int)(it % NH);
        float ss = 0.f; for (int v = 0; v < DV; ++v) { const float x = bf2f(HB[r * D + h * DV + v]); ss += x * x; }
        const float rs = 1.0f / sqrtf(ss / (float)DV + EPS);
        for (int v = 0; v < DV; ++v) { const int c = h * DV + v; RB[r * RBK + c] = f2bf(bf2f(HB[r * D + c]) * rs * p.m_g_head[j * VW + c] * bf2f(O[r * VW + c])); }
    }
}

typedef const __attribute__((address_space(4))) Params* KParams;
__device__ __forceinline__ Params load_params() {
    KParams pp = (KParams)__builtin_amdgcn_kernarg_segment_ptr();
    asm volatile("" : "+s"(pp) :: "memory");
#if defined(__HIP_DEVICE_COMPILE__)
    return *pp;
#else
    return Params{};
#endif
}
#define GT_NT unsigned t_ = threadIdx.x; asm volatile("" : "+v"(t_)); const size_t gtid = (size_t)blockIdx.x * 512 + t_, nthr = (size_t)gridDim.x * 512
__global__ void __launch_bounds__(512, 2) mega(Params p_) {
    extern __shared__ __attribute__((aligned(16))) unsigned char lds[];
    const int tid = threadIdx.x;
    volatile LAS unsigned* misc = (volatile LAS unsigned*)((LAS unsigned char*)lds + LDS_MISC);
    if (tid < 64) misc[tid] = 0u;
    __syncthreads();
    XcdBarrier bar = xcd_barrier_post((unsigned*)(p_.ws + WS_CTL) + CW_BAR, misc + 8);
    const int lo = p_.ph_lo, hi = p_.ph_hi;
#define IN(k) (lo <= (k) && (k) < hi)
#define SEAM(k) do { if (IN((k) + 1)) xcd_barrier(bar); } while (0)
#ifndef PROBE_DOUBLE
#define PROBE_DOUBLE 0
#endif
#define REPP(bit, call) if (PROBE_DOUBLE & (bit)) { __syncthreads(); const Params p = load_params(); call; }
#define NPH(k, call) if (IN(k)) { { const Params p = load_params(); GT_NT; call; } SEAM(k); }
#define OPH(k, call) if (IN(k)) { { const Params p = load_params(); call; } SEAM(k); }
    OPH(0, o_p0(p, (LAS unsigned char*)lds))
    for (int i = 0; i < DEPTH; ++i) {
        const int b = 2 + i * PH_PER_LAYER; const bool ml = (i & 1) == 0;
        OPH(b + 0, o_t1(p, i))
        if (IN(b + 1)) { { const Params p = load_params(); if (o_g1(p, i, (LAS unsigned char*)lds)) fill_tiles(p, (LAS unsigned char*)lds, 4, P0_DEFER, false); } SEAM(b + 1); }
        if (ml) {
            if (IN(b + 2)) { { const Params p = load_params(); o_m1(p, (LAS unsigned char*)lds); } REPP(8, o_m1(p, (LAS unsigned char*)lds)) SEAM(b + 2); }
            OPH(b + 3, o_m2(p))
            if (IN(b + 4)) { { const Params p = load_params(); o_m3(p, i, (LAS unsigned char*)lds); } REPP(16, o_m3(p, i, (LAS unsigned char*)lds)) SEAM(b + 5); }
        } else {
            if (IN(b + 2)) { { const Params p = load_params(); o_rg1(p, i, (LAS unsigned char*)lds); } REPP(32, o_rg1(p, i, (LAS unsigned char*)lds)) SEAM(b + 2); }
            OPH(b + 3, o_rg2(p))
            if (IN(b + 4)) { { const Params p = load_params(); o_rg3(p, i, (LAS unsigned char*)lds); } REPP(64, o_rg3(p, i, (LAS unsigned char*)lds)) SEAM(b + 5); }
        }
        if (IN(b + 6)) { { const Params p = load_params(); if (o_g2(p, i, (LAS unsigned char*)lds)) fill_tiles(p, (LAS unsigned char*)lds, 4, P0_DEFER, false); } SEAM(b + 6); }
        if (IN(b + 7)) { { const Params p = load_params();
            int qv = 0x7fffffff; if (i > 0 && tid == 0) qv = __hip_atomic_load((int*)(p.ws + WS_CTL) + CW_FILLQ, __ATOMIC_RELAXED, __HIP_MEMORY_SCOPE_AGENT);
            o_t2(p, i, (LAS unsigned char*)lds);
            if (i > 0) { if (tid == 0) misc[17] = qv < i * P0_LAYER_E ? 1u : 0u; __syncthreads(); if (misc[17]) fill_tiles(p, (LAS unsigned char*)lds, 2, i * P0_LAYER_E, true); } }
            SEAM(b + 7); }
        if (IN(b + 8)) { { const Params p = load_params(); if (o_g3(p, i, (LAS unsigned char*)lds)) fill_tiles(p, (LAS unsigned char*)lds, 4, P0_DEFER, false); } SEAM(b + 8); }
        if (IN(b + 9)) { { const Params p = load_params(); if (o_g4(p, i, (LAS unsigned char*)lds, IN(b + 8))) fill_tiles(p, (LAS unsigned char*)lds, 2, P0_DEFER, false); } SEAM(b + 9); }
    }
    if (IN(2 + DEPTH * PH_PER_LAYER)) { const Params p = load_params(); o_t1(p, DEPTH); }
#undef IN
#undef SEAM
}

extern "C" void kernel_launch(void* const* d_in, const int* in_sizes, int n_in, void* d_out, int out_size, void* d_ws, size_t ws_size, hipStream_t stream) {
    static int grid = 0;
    if (grid == 0) {
        if (n_in != 25 || in_sizes[0] != NB * SEQ * D || out_size != NB * SEQ * D || ws_size < WS_END) {
            fprintf(stderr, "kernel_launch: unexpected shapes / workspace (n_in %d, in0 %d, out %d, ws %zu < %zu): nothing launched\n", n_in, n_in > 0 ? in_sizes[0] : -1, out_size, ws_size, (size_t)WS_END);
            grid = -1; return;
        }
        int dev = 0, cus = 0, per_cu = 0;
        if (hipGetDevice(&dev) != hipSuccess || hipDeviceGetAttribute(&cus, hipDeviceAttributeMultiprocessorCount, dev) != hipSuccess) { grid = -1; return; }
        if (hipFuncSetAttribute((const void*)mega, hipFuncAttributeMaxDynamicSharedMemorySize, LDS_BYTES) != hipSuccess) { fprintf(stderr, "kernel_launch: hipFuncSetAttribute failed\n"); grid = -1; return; }
        if (hipOccupancyMaxActiveBlocksPerMultiprocessor(&per_cu, (const void*)mega, 512, LDS_BYTES) != hipSuccess || per_cu < 1) fprintf(stderr, "kernel_launch: occupancy query reports %d\n", per_cu);
        (void)hipGetLastError();
        if (cus < 256) { fprintf(stderr, "kernel_launch: %d CUs; this kernel is dealt for 256 resident workgroups: nothing launched\n", cus); grid = -1; return; }
        grid = 256;
    }
    if (grid < 0) return;
    (void)hipMemsetAsync((char*)d_ws + WS_CTL, 0, CTL_BYTES, stream);
    Params p{};
    const float** f = (const float**)&p;
    for (int i = 0; i < 25; ++i) f[i] = (const float*)d_in[i];
    p.out = (float*)d_out; p.ws = (unsigned char*)d_ws;
    p.ph_lo = 0; p.ph_hi = N_PHASES;
    hipLaunchKernelGGL(mega, dim3(grid), dim3(512), LDS_BYTES, stream, p);
}
#endif
```

```cpp
#ifndef HOST_EMU
#include <hip/hip_runtime.h>
#include <cstdio>
#include <cstdint>
#define HD __device__ __forceinline__
#define DEV __device__ __forceinline__
#else
#include <cmath>
#include <cstdio>
#include <cstdint>
#include <cstring>
#define HD inline
#define DEV inline
#endif

#ifndef CFG_D
#define CFG_D 1024
#define CFG_B 8
#define CFG_SEQ 2048
#define CFG_CTX 256
#define CFG_DQK 64
#define CFG_DV 128
#define CFG_DE 512
#endif
constexpr int D = CFG_D, NB = CFG_B, SEQ = CFG_SEQ, CTX = CFG_CTX, DEPTH = 4, NH = 8, DQK = CFG_DQK, DV = CFG_DV, NE = 16, DE = CFG_DE;
constexpr int S = CTX + SEQ;
constexpr int MROWS = NB * S;
constexpr int QKW = NH * DQK, VW = NH * DV, MPROJ = 2 * QKW + 2 * VW + 4 * NH;
constexpr int MPROJ_P = (MPROJ + 255) / 256 * 256;
constexpr int RBW = D / 8;
constexpr int G13 = DE < 128 ? DE : 128;
constexpr int GRIDW = 64;
constexpr float EPS = 1e-6f;
constexpr int UROWS = 2 * MROWS + NE * 256;

typedef unsigned short bf16;
HD unsigned f2u(float f) { unsigned u; memcpy(&u, &f, 4); return u; }
HD float u2f(unsigned u) { float f; memcpy(&f, &u, 4); return f; }
HD bf16 f2bf(float f) { unsigned u = f2u(f); u += 0x7FFFu + ((u >> 16) & 1u); return (bf16)(u >> 16); }
HD float bf2f(bf16 b) { return u2f(((unsigned)b) << 16); }
HD float sigmoidf_(float x) { return 1.0f / (1.0f + expf(-x)); }
HD float siluf_(float x) { return x / (1.0f + expf(-x)); }
HD float logsigmoidf_(float x) { return x >= 0.f ? -log1pf(expf(-x)) : x - log1pf(expf(x)); }
HD float softplusf_(float x) { return x > 0.f ? x + log1pf(expf(-x)) : log1pf(expf(x)); }
HD float geluf_(float x) { return 0.5f * x * (1.0f + tanhf(0.7978845608028654f * (x + 0.044715f * x * x * x))); }

constexpr size_t al256(size_t x) { return (x + 255) / 256 * 256; }
constexpr size_t WS_CTL = 0, CTL_BYTES = 1u << 20;
constexpr size_t WS_MOD = WS_CTL + CTL_BYTES;
constexpr size_t WS_SIL = WS_MOD + al256((size_t)DEPTH * (NB + 1) * 6 * D * 4);
constexpr size_t WS_WINM = WS_SIL + al256((size_t)(NB + 1) * D * 4);
constexpr size_t WS_WOUTM = WS_WINM + al256((size_t)2 * MPROJ_P * D * 2);
constexpr size_t WS_WINR = WS_WOUTM + al256((size_t)2 * D * VW * 2);
constexpr size_t WS_WOUTR = WS_WINR + al256((size_t)2 * 2 * D * D * 2);
constexpr size_t WS_WG = WS_WOUTR + al256((size_t)2 * D * D * 2);
constexpr size_t WS_W13 = WS_WG + al256((size_t)2 * 2 * 8 * 2 * RBW * RBW * 2);
constexpr size_t WS_W2 = WS_W13 + al256((size_t)DEPTH * NE * 2 * DE * D * 2);
constexpr size_t WS_X = WS_W2 + al256((size_t)DEPTH * NE * D * DE * 2);
constexpr size_t SKEW = 0x11100;
constexpr size_t WS_HB = WS_X + al256((size_t)MROWS * D * 4) + SKEW;
constexpr size_t WS_RB = WS_HB + al256((size_t)MROWS * D * 2) + SKEW;
constexpr int RBK = VW > D ? VW : D;
constexpr size_t WS_GT = WS_RB + al256((size_t)MROWS * RBK * 2) + SKEW;
constexpr size_t WS_RTE = WS_GT + al256((size_t)MROWS * 4 * NH * 4);
constexpr size_t WS_RTW = WS_RTE + al256((size_t)MROWS * 2 * 4);
constexpr size_t WS_ELIST = WS_RTW + al256((size_t)MROWS * 2 * 4);
constexpr int NCH = S / 64;
constexpr size_t WS_ND = WS_ELIST + al256((size_t)NE * MROWS * 8);
constexpr size_t WS_SC = WS_ND + al256((size_t)2 * NB * NH * NCH * DQK * 4);
constexpr size_t WS_MS = WS_SC + al256((size_t)2 * NB * NH * NCH * 2 * 4);
constexpr size_t WS_RSUM = WS_MS + al256((size_t)2 * NB * NH * NCH * 4);
constexpr size_t WS_RCIN = WS_RSUM + al256((size_t)2 * NB * NCH * D * 2 * 4);
constexpr size_t WS_BIG = WS_RCIN + al256((size_t)2 * NB * NCH * D * 4);
constexpr size_t SZ_Q = al256((size_t)MROWS * QKW * 2) + SKEW, SZ_V = al256((size_t)MROWS * VW * 2) + SKEW, SZ_DD = al256((size_t)MROWS * D * 2) + SKEW;
constexpr size_t SZ_U = al256((size_t)UROWS * DE * 2);
constexpr size_t cmax(size_t a, size_t b) { return a > b ? a : b; }
constexpr size_t SZ_BIG = cmax(cmax(2 * SZ_Q + 2 * SZ_V, 3 * SZ_DD), SZ_U);
constexpr size_t WS_Q = WS_BIG, WS_K = WS_Q + SZ_Q, WS_V = WS_K + SZ_Q, WS_O = WS_V + SZ_V;
constexpr size_t WS_GY = WS_BIG, WS_XR = WS_GY + SZ_DD, WS_XC = WS_XR + SZ_DD;
constexpr size_t WS_U = WS_BIG;
constexpr size_t WS_BIG2 = WS_BIG + SZ_BIG + SKEW;
constexpr size_t SZ_BIG2 = cmax(al256((size_t)MROWS * RBK * 4), al256((size_t)MROWS * 2 * D * 2)) + SKEW;
constexpr size_t WS_HS = WS_BIG2, WS_Y = WS_BIG2;
constexpr size_t WS_END = WS_BIG2 + SZ_BIG2;

constexpr int CW_BAR = 4096;
constexpr int CW_ECNT = 16384;

struct Params {
    const float *x, *c, *ctx, *c_ctx, *w_ada, *b_ada, *g_mix, *g_ffn, *g_final;
    const float *m_w_in, *m_b_gate, *m_g_head, *m_w_out;
    const float *r_w_in, *r_conv_w, *r_conv_b, *r_w_gate, *r_b_gate, *r_lam, *r_w_out;
    const float *w_router, *b_router, *e_w1, *e_w3, *e_w2;
    float* out; unsigned char* ws;
    int ph_lo, ph_hi;
};
#define WSP(T, off) ((T*)(p.ws + (off)))

HD float pos_embed(int t, int k) {
    const int quarter = D / 4; const int rr = t / GRIDW, cc = t % GRIDW;
    const int q = k % quarter, sec = k / quarter;
    const float f = expf(-9.210340371976184f * (float)q / (float)quarter);
    const float pp = (sec < 2) ? (float)rr : (float)cc;
    const float ang = pp * f;
    return (sec & 1) ? cosf(ang) : sinf(ang);
}
HD void route16(const float* lg, const float* b_router, int& e0, int& e1, float& w0, float& w1) {
    float mx = lg[0];
#pragma unroll
    for (int e = 1; e < NE; ++e) mx = lg[e] > mx ? lg[e] : mx;
    float sc[NE]; float sum = 0.f;
#pragma unroll
    for (int e = 0; e < NE; ++e) { sc[e] = expf(lg[e] - mx); sum += sc[e]; }
    const float inv = 1.0f / sum;
    float gsbest = -3.0e38f; int be0 = 0, be1 = 1; float bs0 = 0.f, bs1 = 0.f;
#pragma unroll
    for (int g = 0; g < 4; ++g) {
        float m1 = -3.0e38f, m2 = -3.0e38f, s1 = 0.f, s2 = 0.f; int i1 = 0, i2 = 0;
#pragma unroll
        for (int i = 0; i < 4; ++i) {
            const float s = sc[4 * g + i] * inv, v = s + b_router[4 * g + i];
            if (v > m1) { m2 = m1; i2 = i1; s2 = s1; m1 = v; i1 = 4 * g + i; s1 = s; }
            else if (v > m2) { m2 = v; i2 = 4 * g + i; s2 = s; }
        }
        const float gs = m1 + m2;
        if (gs > gsbest) { gsbest = gs; be0 = i1; be1 = i2; bs0 = s1; bs1 = s2; }
    }
    e0 = be0; e1 = be1;
    const float t = 1.0f / (bs0 + bs1);
    w0 = bs0 * t; w1 = bs1 * t;
}
HD int atomic_inc_int(int* p_) {
#if defined(__HIP_DEVICE_COMPILE__)
    return atomicAdd(p_, 1);
#else
    return (*p_)++;
#endif
}
HD int order_pos(int d, int o) { return d == 0 ? o : (o < CTX ? CTX - 1 - o : S - 1 - (o - CTX)); }
struct U4 { unsigned x, y, z, w; };
HD float dot_bf(const bf16* a, const bf16* b, int K) {
    float s = 0.f;
    for (int k = 0; k < K; k += 8) {
        const U4 va = *(const U4*)(a + k), vb = *(const U4*)(b + k);
        s += u2f(va.x << 16) * u2f(vb.x << 16); s += u2f(va.x & 0xFFFF0000u) * u2f(vb.x & 0xFFFF0000u);
        s += u2f(va.y << 16) * u2f(vb.y << 16); s += u2f(va.y & 0xFFFF0000u) * u2f(vb.y & 0xFFFF0000u);
        s += u2f(va.z << 16) * u2f(vb.z << 16); s += u2f(va.z & 0xFFFF0000u) * u2f(vb.z & 0xFFFF0000u);
        s += u2f(va.w << 16) * u2f(vb.w << 16); s += u2f(va.w & 0xFFFF0000u) * u2f(vb.w & 0xFFFF0000u);
    }
    return s;
}

HD void conv_T_item(bf16* dst, const float* src, int K, int N, size_t idx) { const int n = (int)(idx / K), k = (int)(idx % K); dst[idx] = n < N ? f2bf(src[(size_t)k * N + n]) : (bf16)0; }
HD void n_p0a(const Params& p, size_t gtid, size_t nthr) {
    float* SIL = WSP(float, WS_SIL);
    for (size_t i = gtid; i < (size_t)(NB + 1) * D; i += nthr) { const int bp = (int)(i / D), k = (int)(i % D); SIL[i] = siluf_(bp < NB ? p.c[bp * D + k] : p.c_ctx[k]); }
    for (int j = 0; j < 2; ++j) {
        bf16* winm = WSP(bf16, WS_WINM) + (size_t)j * MPROJ_P * D;
        for (size_t i = gtid; i < (size_t)MPROJ_P * D; i += nthr) conv_T_item(winm, p.m_w_in + (size_t)j * D * MPROJ, D, MPROJ, i);
        bf16* woutm = WSP(bf16, WS_WOUTM) + (size_t)j * D * VW;
        for (size_t i = gtid; i < (size_t)D * VW; i += nthr) conv_T_item(woutm, p.m_w_out + (size_t)j * VW * D, VW, D, i);
        bf16* winr = WSP(bf16, WS_WINR) + (size_t)j * 2 * D * D;
        for (size_t i = gtid; i < (size_t)2 * D * D; i += nthr) conv_T_item(winr, p.r_w_in + (size_t)j * D * 2 * D, D, 2 * D, i);
        bf16* woutr = WSP(bf16, WS_WOUTR) + (size_t)j * D * D;
        for (size_t i = gtid; i < (size_t)D * D; i += nthr) conv_T_item(woutr, p.r_w_out + (size_t)j * D * D, D, D, i);
        for (int dn = 0; dn < 16; ++dn) {
            bf16* wg = WSP(bf16, WS_WG) + ((size_t)j * 16 + dn) * 2 * RBW * RBW;
            for (size_t i = gtid; i < (size_t)2 * RBW * RBW; i += nthr) conv_T_item(wg, p.r_w_gate + ((size_t)j * 16 + dn) * RBW * 2 * RBW, RBW, 2 * RBW, i);
        }
    }
    for (int ie = 0; ie < DEPTH * NE; ++ie) {
        bf16* w13 = WSP(bf16, WS_W13) + (size_t)ie * 2 * DE * D;
        const float* w1 = p.e_w1 + (size_t)ie * D * DE; const float* w3 = p.e_w3 + (size_t)ie * D * DE;
        for (size_t i = gtid; i < (size_t)2 * DE * D; i += nthr) {
            const int rr = (int)(i / D), k = (int)(i % D); const int blk = rr / (2 * G13), w = (rr / G13) & 1, hc = blk * G13 + rr % G13;
            w13[i] = f2bf((w ? w3 : w1)[(size_t)k * DE + hc]);
        }
        bf16* w2 = WSP(bf16, WS_W2) + (size_t)ie * D * DE;
        for (size_t i = gtid; i < (size_t)D * DE; i += nthr) conv_T_item(w2, p.e_w2 + (size_t)ie * DE * D, DE, D, i);
    }
}
HD void n_p0b(const Params& p, size_t gtid, size_t nthr) {
    const float* SIL = WSP(float, WS_SIL); float* MOD = WSP(float, WS_MOD);
    for (size_t it = gtid; it < (size_t)DEPTH * 6 * D; it += nthr) {
        const int i = (int)(it / (6 * D)), n = (int)(it % (6 * D));
        float acc[NB + 1];
        for (int bp = 0; bp <= NB; ++bp) acc[bp] = p.b_ada[i * 6 * D + n];
        const float* w = p.w_ada + (size_t)i * D * 6 * D + n;
        for (int k = 0; k < D; ++k) { const float wv = w[(size_t)k * 6 * D]; for (int bp = 0; bp <= NB; ++bp) acc[bp] += SIL[bp * D + k] * wv; }
        for (int bp = 0; bp <= NB; ++bp) MOD[((size_t)i * (NB + 1) + bp) * 6 * D + n] = acc[bp];
    }
}
HD void n_t1(const Params& p, int i, size_t gtid, size_t nthr) {
    float* X = WSP(float, WS_X); bf16* HB = WSP(bf16, WS_HB); const bf16* Y = WSP(bf16, WS_Y); const float* MOD = WSP(float, WS_MOD);
    for (size_t r = gtid; r < (size_t)MROWS; r += nthr) {
        const int b = (int)(r / S), s = (int)(r % S); const bool isctx = s < CTX; const int bp = isctx ? NB : b;
        if (i == DEPTH && isctx) continue;
        float* xr = X + r * D;
        float ss = 0.f;
        for (int k = 0; k < D; ++k) {
            float v;
            if (i == 0) v = isctx ? p.ctx[((size_t)b * CTX + s) * D + k] : p.x[((size_t)b * SEQ + (s - CTX)) * D + k] + pos_embed(s - CTX, k);
            else { const float g5 = MOD[((size_t)(i - 1) * (NB + 1) + bp) * 6 * D + 5 * D + k]; v = xr[k] + g5 * (bf2f(Y[(r * 2 + 0) * D + k]) + bf2f(Y[(r * 2 + 1) * D + k])); }
            xr[k] = v; ss += v * v;
        }
        const float rstd = 1.0f / sqrtf(ss / (float)D + EPS);
        if (i == DEPTH) { float* o = p.out + ((size_t)b * SEQ + (s - CTX)) * D; for (int k = 0; k < D; ++k) o[k] = xr[k] * rstd * p.g_final[k]; continue; }
        const float* mod = MOD + ((size_t)i * (NB + 1) + bp) * 6 * D;
        for (int k = 0; k < D; ++k) HB[r * D + k] = f2bf(xr[k] * rstd * p.g_mix[i * D + k] * (1.0f + mod[D + k]) + mod[k]);
    }
}
HD void epi_g1m(const Params& p, int j, size_t r, int n, float v) {
    if (n < QKW) WSP(bf16, WS_Q)[r * QKW + n] = f2bf(v * (1.0f / sqrtf((float)DQK)));
    else if (n < 2 * QKW) WSP(bf16, WS_K)[r * QKW + n - QKW] = f2bf(v);
    else if (n < 2 * QKW + VW) WSP(bf16, WS_V)[r * VW + n - 2 * QKW] = f2bf(v);
    else if (n < 2 * QKW + 2 * VW) WSP(bf16, WS_O)[r * VW + n - 2 * QKW - VW] = f2bf(sigmoidf_(v));
    else if (n < MPROJ) { const int g = n - 2 * QKW - 2 * VW, gi = g / NH; v += p.m_b_gate[j * 4 * NH + g]; if (gi & 1) v = logsigmoidf_(v); WSP(float, WS_GT)[r * 4 * NH + g] = v; }
}
HD void epi_g1r(const Params& p, size_t r, int n, float v) {
    if (n < D) WSP(bf16, WS_GY)[r * D + n] = f2bf(geluf_(v)); else WSP(bf16, WS_XR)[r * D + n - D] = f2bf(v);
}
HD void n_g1(const Params& p, int i, size_t gtid, size_t nthr) {
    const bf16* HB = WSP(bf16, WS_HB); const int j = i >> 1;
    if ((i & 1) == 0) {
        const bf16* W = WSP(bf16, WS_WINM) + (size_t)j * MPROJ_P * D;
        for (size_t it = gtid; it < (size_t)MROWS * MPROJ; it += nthr) { const size_t r = it / MPROJ; const int n = (int)(it % MPROJ); epi_g1m(p, j, r, n, dot_bf(HB + r * D, W + (size_t)n * D, D)); }
    } else {
        const bf16* W = WSP(bf16, WS_WINR) + (size_t)j * 2 * D * D;
        for (size_t it = gtid; it < (size_t)MROWS * 2 * D; it += nthr) { const size_t r = it / (2 * D); const int n = (int)(it % (2 * D)); epi_g1r(p, r, n, dot_bf(HB + r * D, W + (size_t)n * D, D)); }
    }
}
HD void n_mlstm_dir(const Params& p, int d, size_t gtid, size_t nthr) {
    const bf16* Q = WSP(bf16, WS_Q); const bf16* Kb = WSP(bf16, WS_K); const bf16* V = WSP(bf16, WS_V); const float* GT = WSP(float, WS_GT); float* HS = WSP(float, WS_HS);
    for (size_t it = gtid; it < (size_t)NB * NH * DV; it += nthr) {
        const int b = (int)(it / (NH * DV)), h = (int)((it / DV) % NH), v = (int)(it % DV);
        float C[DQK], nn[DQK]; float m = 0.f;
#pragma unroll
        for (int k = 0; k < DQK; ++k) { C[k] = 0.f; nn[k] = 0.f; }
        for (int o = 0; o < S; ++o) {
            const size_t r = (size_t)b * S + order_pos(d, o);
            const float ig = GT[r * 4 * NH + (2 * d) * NH + h], lf = GT[r * 4 * NH + (2 * d + 1) * NH + h];
            const float mn = fmaxf(lf + m, ig), fd = expf(lf + m - mn), iw = expf(ig - mn); m = mn;
            const float vv = bf2f(V[r * VW + h * DV + v]);
            float num = 0.f, den = 0.f;
#pragma unroll
            for (int k = 0; k < DQK; ++k) {
                const float kk = bf2f(Kb[r * QKW + h * DQK + k]), qq = bf2f(Q[r * QKW + h * DQK + k]);
                C[k] = fd * C[k] + iw * kk * vv; nn[k] = fd * nn[k] + iw * kk; num += qq * C[k]; den += qq * nn[k];
            }
            const float hv = num / fmaxf(fabsf(den), expf(-m));
            float* dst = HS + r * VW + h * DV + v;
            if (d == 0) *dst = hv; else *dst += hv;
        }
    }
}
HD void n_mlstm_out(const Params& p, int i, size_t gtid, size_t nthr) {
    const float* HS = WSP(float, WS_HS); const bf16* O = WSP(bf16, WS_O); bf16* RB = WSP(bf16, WS_RB); const int j = i >> 1;
    for (size_t it = gtid; it < (size_t)MROWS * NH; it += nthr) {
        const size_t r = it / NH; const int h = (int)(it % NH);
        float ss = 0.f; for (int v = 0; v < DV; ++v) { const float x = HS[r * VW + h * DV + v]; ss += x * x; }
        const float rs = 1.0f / sqrtf(ss / (float)DV + EPS);
        for (int v = 0; v < DV; ++v) { const int c = h * DV + v; RB[r * RBK + c] = f2bf(HS[r * VW + c] * rs * p.m_g_head[j * VW + c] * bf2f(O[r * VW + c])); }
    }
}
HD void n_rg_conv(const Params& p, int i, size_t gtid, size_t nthr) {
    const bf16* XR = WSP(bf16, WS_XR); bf16* XC = WSP(bf16, WS_XC); const int j = i >> 1;
    for (size_t it = gtid; it < (size_t)MROWS * D; it += nthr) {
        const size_t r = it / D; const int ch = (int)(it % D); const int s = (int)(r % S); const int lo = s < CTX ? 0 : CTX, hi = s < CTX ? CTX : S;
        float y = p.r_conv_b[j * D + ch];
        for (int t = 0; t < 4; ++t) { const int ss = s + t - 2; if (ss >= lo && ss < hi) y += p.r_conv_w[(j * 4 + t) * D + ch] * bf2f(XR[(r + t - 2) * D + ch]); }
        XC[it] = f2bf(y);
    }
}
HD void n_rg_dir(const Params& p, int i, int d, size_t gtid, size_t nthr) {
    const bf16* XC = WSP(bf16, WS_XC); float* HS = WSP(float, WS_HS); const int j = i >> 1;
    for (size_t it = gtid; it < (size_t)NB * D; it += nthr) {
        const int b = (int)(it / D), ch = (int)(it % D), n = ch / RBW, jc = ch % RBW;
        const bf16* wg = WSP(bf16, WS_WG) + (((size_t)j * 2 + d) * 8 + n) * 2 * RBW * RBW;
        const float* bg = p.r_b_gate + (((size_t)j * 2 + d) * 8 + n) * 2 * RBW;
        const float sp = softplusf_(-p.r_lam[(j * 2 + d) * D + ch]);
        float h = 0.f;
        for (int o = 0; o < S; ++o) {
            const size_t r = (size_t)b * S + order_pos(d, o);
            const float gr = bg[jc] + dot_bf(XC + r * D + n * RBW, wg + (size_t)jc * RBW, RBW);
            const float gi = bg[RBW + jc] + dot_bf(XC + r * D + n * RBW, wg + (size_t)(RBW + jc) * RBW, RBW);
            const float rr = sigmoidf_(gr), ii = sigmoidf_(gi), la = -8.0f * rr * sp, a = expf(la);
            const float bx = sqrtf(-expm1f(2.0f * la)) * (ii * bf2f(XC[r * D + ch]));
            h = a * h + bx;
            float* dst = HS + r * RBK + ch;
            if (d == 0) *dst = h; else *dst += h;
        }
    }
}
HD void n_rg_out(const Params& p, size_t gtid, size_t nthr) {
    const float* HS = WSP(float, WS_HS); const bf16* GY = WSP(bf16, WS_GY); bf16* RB = WSP(bf16, WS_RB);
    for (size_t it = gtid; it < (size_t)MROWS * D; it += nthr) { const size_t r = it / D; const int ch = (int)(it % D); RB[r * RBK + ch] = f2bf(bf2f(GY[it]) * HS[r * RBK + ch]); }
}
HD void n_g2(const Params& p, int i, size_t gtid, size_t nthr) {
    const bf16* RB = WSP(bf16, WS_RB); bf16* HB = WSP(bf16, WS_HB); const int j = i >> 1; const int K = (i & 1) ? D : VW;
    const bf16* W = (i & 1) ? WSP(bf16, WS_WOUTR) + (size_t)j * D * D : WSP(bf16, WS_WOUTM) + (size_t)j * D * VW;
    for (size_t it = gtid; it < (size_t)MROWS * D; it += nthr) {
        const size_t r = it / D; const int n = (int)(it % D);
        if (i == DEPTH - 1 && (int)(r % S) < CTX) continue;
        HB[it] = f2bf(dot_bf(RB + r * RBK, W + (size_t)n * K, K));
    }
}
HD void n_t2(const Params& p, int i, size_t gtid, size_t nthr) {
    float* X = WSP(float, WS_X); bf16* HB = WSP(bf16, WS_HB); const float* MOD = WSP(float, WS_MOD);
    int* RTE = WSP(int, WS_RTE); float* RTW = WSP(float, WS_RTW); int* EL = WSP(int, WS_ELIST); int* ECNT = WSP(int, WS_CTL) + CW_ECNT + i * NE;
    for (size_t r = gtid; r < (size_t)MROWS; r += nthr) {
        const int b = (int)(r / S), s = (int)(r % S); const bool isctx = s < CTX; const int bp = isctx ? NB : b;
        if (i == DEPTH - 1 && isctx) continue;
        const float* mod = MOD + ((size_t)i * (NB + 1) + bp) * 6 * D;
        float* xr = X + r * D; float ss = 0.f;
        for (int k = 0; k < D; ++k) { const float v = xr[k] + mod[2 * D + k] * bf2f(HB[r * D + k]); xr[k] = v; ss += v * v; }
        const float rstd = 1.0f / sqrtf(ss / (float)D + EPS);
        float lg[NE]; for (int e = 0; e < NE; ++e) lg[e] = 0.f;
        for (int k = 0; k < D; ++k) {
            const float h = xr[k] * rstd * p.g_ffn[i * D + k] * (1.0f + mod[4 * D + k]) + mod[3 * D + k];
            HB[r * D + k] = f2bf(h);
            for (int e = 0; e < NE; ++e) lg[e] += h * p.w_router[k * NE + e];
        }
        int e0, e1; float w0, w1; route16(lg, p.b_router, e0, e1, w0, w1);
        RTE[r * 2] = e0; RTE[r * 2 + 1] = e1; RTW[r * 2] = w0; RTW[r * 2 + 1] = w1;
        const int p0 = atomic_inc_int(ECNT + e0); EL[(size_t)e0 * MROWS + p0] = (int)r * 2;
        const int p1 = atomic_inc_int(ECNT + e1); EL[(size_t)e1 * MROWS + p1] = (int)r * 2 + 1;
    }
}
HD int moe_locate(const Params& p, int i, int tile, int& e_, int& tb_, int& cnt_) {
    const int* ECNT = WSP(int, WS_CTL) + CW_ECNT + i * NE; int acc = 0; e_ = -1; tb_ = 0; cnt_ = 0;
#pragma unroll
    for (int e = 0; e < NE; ++e) { const int c = ECNT[e], nt = (c + 255) / 256; if (tile >= acc && tile < acc + nt) { e_ = e; tb_ = acc; cnt_ = c; } acc += nt; }
    return acc;
}
HD void n_g3(const Params& p, int i, size_t gtid, size_t nthr) {
    int e, tb, cnt; const int ntile = moe_locate(p, i, 0, e, tb, cnt);
    const bf16* HB = WSP(bf16, WS_HB); bf16* U = WSP(bf16, WS_U); const int* EL = WSP(int, WS_ELIST);
    for (size_t it = gtid; it < (size_t)ntile * 256 * DE; it += nthr) {
        const int ur = (int)(it / DE), hc = (int)(it % DE); moe_locate(p, i, ur / 256, e, tb, cnt);
        const int pos = ur - tb * 256; if (pos >= cnt) continue;
        const size_t row = (size_t)(EL[(size_t)e * MROWS + pos] >> 1);
        const bf16* w13 = WSP(bf16, WS_W13) + ((size_t)i * NE + e) * 2 * DE * D;
        const int rr1 = (hc / G13) * 2 * G13 + hc % G13;
        const float a = dot_bf(HB + row * D, w13 + (size_t)rr1 * D, D), bb = dot_bf(HB + row * D, w13 + (size_t)(rr1 + G13) * D, D);
        U[(size_t)ur * DE + hc] = f2bf(siluf_(a) * bb);
    }
}
HD void n_g4(const Params& p, int i, size_t gtid, size_t nthr) {
    int e, tb, cnt; const int ntile = moe_locate(p, i, 0, e, tb, cnt);
    const bf16* U = WSP(bf16, WS_U); bf16* Y = WSP(bf16, WS_Y); const int* EL = WSP(int, WS_ELIST); const float* RTW = WSP(float, WS_RTW);
    for (size_t it = gtid; it < (size_t)ntile * 256 * D; it += nthr) {
        const int ur = (int)(it / D), n = (int)(it % D); moe_locate(p, i, ur / 256, e, tb, cnt);
        const int pos = ur - tb * 256; if (pos >= cnt) continue;
        const int ent = EL[(size_t)e * MROWS + pos];
        const bf16* w2 = WSP(bf16, WS_W2) + ((size_t)i * NE + e) * D * DE;
        Y[(size_t)ent * D + n] = f2bf(RTW[ent] * dot_bf(U + (size_t)ur * DE, w2 + (size_t)n * DE, DE));
    }
}

constexpr int PH_PER_LAYER = 10, N_PHASES = 2 + DEPTH * PH_PER_LAYER + 1;
#ifndef HOST_EMU
__host__ __device__
#endif
inline bool phase_used(int ph) {
    if (ph < 2 || ph >= 2 + DEPTH * PH_PER_LAYER) return true;
    const int i = (ph - 2) / PH_PER_LAYER, k = (ph - 2) % PH_PER_LAYER;
    if ((i & 1) == 0 && k == 5) return false;
    return true;
}
#define RUN_NAIVE(call) do { call; } while (0)
HD void run_phase(const Params& p, int ph, size_t gtid, size_t nthr) {
    if (ph == 0) { n_p0a(p, gtid, nthr); return; }
    if (ph == 1) { n_p0b(p, gtid, nthr); return; }
    if (ph == 2 + DEPTH * PH_PER_LAYER) { n_t1(p, DEPTH, gtid, nthr); return; }
    const int i = (ph - 2) / PH_PER_LAYER, k = (ph - 2) % PH_PER_LAYER; const bool ml = (i & 1) == 0;
    switch (k) {
        case 0: n_t1(p, i, gtid, nthr); break;
        case 1: n_g1(p, i, gtid, nthr); break;
        case 2: if (ml) n_mlstm_dir(p, 0, gtid, nthr); else n_rg_conv(p, i, gtid, nthr); break;
        case 3: if (ml) n_mlstm_dir(p, 1, gtid, nthr); else n_rg_dir(p, i, 0, gtid, nthr); break;
        case 4: if (ml) n_mlstm_out(p, i, gtid, nthr); else n_rg_dir(p, i, 1, gtid, nthr); break;
        case 5: if (!ml) n_rg_out(p, gtid, nthr); break;
        case 6: n_g2(p, i, gtid, nthr); break;
        case 7: n_t2(p, i, gtid, nthr); break;
        case 8: n_g3(p, i, gtid, nthr); break;
        case 9: n_g4(p, i, gtid, nthr); break;
    }
}

#ifndef HOST_EMU
#define XB_TMO      128
#define XB_XCNT(j)  (256  + 64 * (j))
#define XB_XSUB(j)  (1280 + 64 * (j))
#define XB_XGEN(j)  (2304 + 64 * (j))
#define XB_TOP      3328
#define XB_TOPGEN   3392
#define XCD_BAR_WORDS 3456
#define XB_SPIN_CAP (1u << 18)
#define LAS __attribute__((address_space(3)))

__device__ __forceinline__ unsigned xb_ld(unsigned* p)              { return __hip_atomic_load(p, __ATOMIC_RELAXED, __HIP_MEMORY_SCOPE_AGENT); }
__device__ __forceinline__ unsigned xb_add(unsigned* p, unsigned v) { return __hip_atomic_fetch_add(p, v, __ATOMIC_RELAXED, __HIP_MEMORY_SCOPE_AGENT); }
__device__ __forceinline__ unsigned xb_xcc_id() { return (unsigned)__builtin_amdgcn_s_getreg((3 << 11) | 20) & 0xFu; }
#define XB_SPIN(cond, bar) do { unsigned _sp = 0; while (cond) { __builtin_amdgcn_s_sleep(1); \
    if ((++_sp & 255u) == 0u) { if (xb_ld(&(bar)[XB_TMO])) break; if (_sp > XB_SPIN_CAP) { atomicAdd(&(bar)[XB_TMO], 1u); break; } } } } while (0)

struct XcdBarrier {
    unsigned* bar; unsigned x;
    volatile LAS unsigned* st;
};

__device__ __forceinline__ XcdBarrier xcd_barrier_post(unsigned* bar, volatile LAS unsigned* st) {
    XcdBarrier b; b.bar = bar; b.x = xb_xcc_id(); b.st = st;
    if (threadIdx.x == 0) (void)xb_add(&bar[XB_XCNT(b.x)], 1u);
    return b;
}
__device__ __forceinline__ void xb_ld16(const unsigned* p0, unsigned (&c)[16]) {
    asm volatile(
        "global_load_dword %0, %16, off sc1\n\tglobal_load_dword %1, %16, off offset:256 sc1\n\tglobal_load_dword %2, %16, off offset:512 sc1\n\tglobal_load_dword %3, %16, off offset:768 sc1\n\t"
        "global_load_dword %4, %16, off offset:1024 sc1\n\tglobal_load_dword %5, %16, off offset:1280 sc1\n\tglobal_load_dword %6, %16, off offset:1536 sc1\n\tglobal_load_dword %7, %16, off offset:1792 sc1\n\t"
        "global_load_dword %8, %16, off offset:2048 sc1\n\tglobal_load_dword %9, %16, off offset:2304 sc1\n\tglobal_load_dword %10, %16, off offset:2560 sc1\n\tglobal_load_dword %11, %16, off offset:2816 sc1\n\t"
        "global_load_dword %12, %16, off offset:3072 sc1\n\tglobal_load_dword %13, %16, off offset:3328 sc1\n\tglobal_load_dword %14, %16, off offset:3584 sc1\n\tglobal_load_dword %15, %16, off offset:3840 sc1\n\t"
        "s_waitcnt vmcnt(0)"
        : "=&v"(c[0]), "=&v"(c[1]), "=&v"(c[2]), "=&v"(c[3]), "=&v"(c[4]), "=&v"(c[5]), "=&v"(c[6]), "=&v"(c[7]), "=&v"(c[8]), "=&v"(c[9]), "=&v"(c[10]), "=&v"(c[11]), "=&v"(c[12]), "=&v"(c[13]), "=&v"(c[14]), "=&v"(c[15])
        : "v"(p0) : "memory");
}
__device__ __forceinline__ void xcd_barrier_complete(unsigned* bar, unsigned x, unsigned& nloc, unsigned& nx) {
    const unsigned G = gridDim.x * gridDim.y * gridDim.z;
    unsigned sum, cnt, mine, sp = 0u;
    for (;;) {
        sum = 0u; cnt = 0u; mine = 0u;
        unsigned cv[16]; xb_ld16(bar + XB_XCNT(0), cv);
#pragma unroll
        for (unsigned j = 0; j < 16; ++j) { const unsigned c = cv[j]; sum += c; cnt += (c > 0u) ? 1u : 0u; mine = (j == x) ? c : mine; }
        if (sum == G) break;
        __builtin_amdgcn_s_sleep(1);
        if ((++sp & 255u) == 0u) { if (xb_ld(&bar[XB_TMO])) break; if (sp > XB_SPIN_CAP) { atomicAdd(&bar[XB_TMO], 1u); break; } }
    }
    nloc = mine > 0u ? mine : 1u; nx = cnt > 0u ? cnt : 1u;
}

__device__ __forceinline__ void xcd_barrier(const XcdBarrier& b) {
    asm volatile("s_waitcnt vmcnt(0)" ::: "memory");
    __syncthreads();
    if (threadIdx.x == 0) {
        unsigned* bar = b.bar;
        __builtin_amdgcn_s_waitcnt(0);
        unsigned nloc = b.st[0], nx = b.st[1];
        if (nloc == 0u) { xcd_barrier_complete(bar, b.x, nloc, nx); b.st[0] = nloc; b.st[1] = nx; }
        const unsigned old = xb_add(&bar[XB_XSUB(b.x)], 1u);
        const unsigned gen = old / nloc;
        if (old + 1u == (gen + 1u) * nloc) {
            __builtin_amdgcn_fence(__ATOMIC_RELEASE, "agent");
            asm volatile("s_waitcnt vmcnt(0)" ::: "memory");
            const unsigned og = xb_add(&bar[XB_TOP], 1u);
            const unsigned tg = og / nx;
            if (og + 1u == (tg + 1u) * nx) xb_add(&bar[XB_TOPGEN], 1u);
            else XB_SPIN(xb_ld(&bar[XB_TOPGEN]) == tg, bar);
            __builtin_amdgcn_fence(__ATOMIC_ACQUIRE, "agent");
            xb_add(&bar[XB_XGEN(b.x)], 1u);
            asm volatile("s_waitcnt vmcnt(0)" ::: "memory");
        } else {
            XB_SPIN(xb_ld(&bar[XB_XGEN(b.x)]) == gen, bar);
            __builtin_amdgcn_fence(__ATOMIC_ACQUIRE, "agent");
            asm volatile("s_waitcnt vmcnt(0)" ::: "memory");
        }
    }
    __syncthreads();
}


constexpr int LDS_BYTES = 147456;
constexpr int LDS_MISC = 131072;
namespace gm {
typedef short bf16x8 __attribute__((ext_vector_type(8)));
typedef float f32x4 __attribute__((ext_vector_type(4)));
typedef unsigned u32x4 __attribute__((ext_vector_type(4)));
constexpr int BM = 256, BK = 64, HALF = 128, HTB = HALF * BK * 2, STAGE_BYTES = 8 * HTB, NXCD = 8, WGM = 8;
__device__ __forceinline__ int lds_byte(int r, int c) { const int st = (r >> 4) * 2 + (c >> 5), rr = r & 15, cc = c & 31, ob = rr * 64 + cc * 2; return st * 1024 + (ob ^ (((ob >> 9) & 1) << 5)); }
__device__ __forceinline__ void stage_rc(int b, int& R, int& C) { const int st = b / 1024, sb = b % 1024, swz = sb ^ (((sb >> 9) & 1) << 5); R = (st >> 1) * 16 + swz / 64; C = (st & 1) * 32 + (swz % 64) / 2; }
__device__ __forceinline__ int perm32(int rho) { const int n = rho >> 4, i = rho & 15; return 8 * (i >> 2) + 4 * n + (i & 3); }
__device__ __forceinline__ unsigned cvt_pk_bf16(float lo, float hi) {
    typedef __bf16 bf2_t __attribute__((ext_vector_type(2))); typedef float f2_t __attribute__((ext_vector_type(2)));
    const bf2_t r = __builtin_convertvector((f2_t){lo, hi}, bf2_t); return __builtin_bit_cast(unsigned, r); }
__device__ __forceinline__ float fsigmoid(float x) { return __builtin_amdgcn_rcpf(1.0f + __expf(-x)); }

typedef int i32x2 __attribute__((ext_vector_type(2)));
struct GUnit { const char* B; int arow0, pm, pn, e, cnt, tb; };

template <int MT, class Epi, class Sched>
__device__ __forceinline__ void gemm_phase(LAS unsigned char* lds, const char* A0, const int K, const Sched& S, const Epi& E) {
    int tid_ = threadIdx.x; asm volatile("" : "+v"(tid_));
    const int tid = tid_, wid = __builtin_amdgcn_readfirstlane(tid >> 6), lane = tid & 63, wr = wid >> 2, wc = wid & 3, fr = lane & 15, fq = lane >> 4;
    const int nt = K / BK;
    int R0, C0; stage_rc(tid * 16, R0, C0);
    const unsigned voffB = (unsigned)(((R0 & ~31) + perm32(R0 & 31)) * K + C0) * 2u;
    const size_t qstep = (size_t)64 * K * 2;
    const size_t astep = (size_t)(16 * MT) * K * 2;
    const size_t kstep = (size_t)(BK * 2);
    const size_t hstep = (size_t)HALF * K * 2;
    const unsigned ldsw = (unsigned)wid * 1024u;
    const int aoff = lds_byte(wr * 64 + fr, fq * 8), boff = lds_byte(wc * 32 + fr, fq * 8);
#define PG8_SA(b, h) (((b) * 2 + (h)) * HTB)
#define PG8_SB(b, h) ((4 + (b) * 2 + (h)) * HTB)
#define PG8_STAGEB(bufoff, gbase) do { _Pragma("unroll") for (int _i = 0; _i < 2; ++_i) \
        __builtin_amdgcn_global_load_lds((const unsigned*)((const char*)(gbase) + _i * qstep + voffB), (LAS unsigned*)(lds + (bufoff) + ldsw + _i * 8192), 16, 0, 0); } while (0)
#define PG8_STAGEA(bufoff, kbyte, h) do { _Pragma("unroll") for (int _i = 0; _i < 2; ++_i) { \
        const char* _src = Sched::GATHER ? A0 + (size_t)va[(h) * 2 + _i] + (size_t)(kbyte) : A0 + ((size_t)(kbyte) + ((h) * 2 + _i) * astep) + (size_t)va[0]; \
        __builtin_amdgcn_global_load_lds((const unsigned*)_src, (LAS unsigned*)(lds + (bufoff) + ldsw + _i * 8192), 16, 0, 0); } } while (0)
#define PG8_LDA(dst, b, h) do { _Pragma("unroll") for (int m = 0; m < MT; ++m) _Pragma("unroll") for (int k = 0; k < 2; ++k) dst[m][k] = *(const LAS bf16x8*)(lds + PG8_SA(b, h) + aoff + m * 2048 + k * 1024); } while (0)
#define PG8_LDB(dst, b, h) do { _Pragma("unroll") for (int n = 0; n < 2; ++n) _Pragma("unroll") for (int k = 0; k < 2; ++k) dst[n][k] = *(const LAS bf16x8*)(lds + PG8_SB(b, h) + boff + n * 2048 + k * 1024); } while (0)
#define PG8_MMA(ai, bj, At, Bt) do { __builtin_amdgcn_s_setprio(1); _Pragma("unroll") for (int m = 0; m < MT; ++m) _Pragma("unroll") for (int n = 0; n < 2; ++n) _Pragma("unroll") for (int k = 0; k < 2; ++k) \
        acc[ai][bj][m][n] = __builtin_amdgcn_mfma_f32_16x16x32_bf16(Bt[n][k], At[m][k], acc[ai][bj][m][n], 0, 0, 0); __builtin_amdgcn_s_setprio(0); } while (0)
#define PG8_WAIT_V(n) asm volatile("s_waitcnt vmcnt(" #n ")" ::: "memory")
#define PG8_WAIT_L(n) asm volatile("s_waitcnt lgkmcnt(" #n ")" ::: "memory")
#define PG8_BAR __builtin_amdgcn_s_barrier()
#define PG8_SCHED __builtin_amdgcn_sched_barrier(0)
#define PG8_AOFFS(dst, u) do { _Pragma("unroll") for (int _h = 0; _h < 2; ++_h) _Pragma("unroll") for (int _i = 0; _i < 2; ++_i) \
        if (Sched::GATHER || (_h + _i == 0)) dst[_h * 2 + _i] = ((unsigned)S.arow(u, _h * 128 + _i * 64 + R0) * (unsigned)K + (unsigned)C0) * 2u; } while (0)
    GUnit cur, nxt; int ui = 0;
    if (!S.next(0, cur)) return;
    f32x4 acc[2][2][MT][2];
#pragma unroll
    for (int a = 0; a < 2; ++a)
#pragma unroll
        for (int b = 0; b < 2; ++b)
#pragma unroll
            for (int m = 0; m < MT; ++m)
#pragma unroll
                for (int n = 0; n < 2; ++n) acc[a][b][m][n] = (f32x4){0.f, 0.f, 0.f, 0.f};
    bf16x8 At[MT][2], B0[2][2], B1[2][2];
    unsigned va[4], vn[4] = {0u, 0u, 0u, 0u};
    PG8_AOFFS(va, cur);
    const char* cB = cur.B;
    PG8_STAGEB(PG8_SB(0, 0), cB); PG8_STAGEB(PG8_SB(0, 1), cB + hstep); PG8_STAGEA(PG8_SA(0, 0), 0, 0); PG8_STAGEA(PG8_SA(0, 1), 0, 1);
    if (wr == 1) PG8_BAR;
    PG8_WAIT_V(2); PG8_BAR;
    PG8_STAGEB(PG8_SB(1, 0), cB + kstep); PG8_STAGEA(PG8_SA(1, 0), kstep, 0); PG8_STAGEB(PG8_SB(1, 1), cB + hstep + kstep);
    PG8_WAIT_V(6); PG8_BAR;
    for (;;) {
        const bool has_next = S.next(ui + 1, nxt);
        const char* nB = has_next ? nxt.B : cB;
        for (int t = 0; t < nt; t += 2) {
            const bool last = (t == nt - 2);
            const size_t k1 = (size_t)(t + 1) * kstep;
            const size_t k2 = last ? (size_t)0 : (size_t)(t + 2) * kstep; const char* b2 = last ? nB : cB + (size_t)(t + 2) * kstep;
            const size_t k3 = k2 + kstep; const char* b3 = b2 + kstep;
            PG8_LDB(B0, 0, 0); PG8_LDB(B1, 0, 1); PG8_SCHED; PG8_LDA(At, 0, 0); PG8_STAGEA(PG8_SA(1, 1), k1, 1);
            if (Sched::GATHER) {
                if (t == nt - 4 && has_next) { PG8_AOFFS(vn, nxt); }
                if (last && has_next) { _Pragma("unroll") for (int _k = 0; _k < 4; ++_k) va[_k] = vn[_k]; } }
            else if (last && has_next) { PG8_AOFFS(va, nxt); }
            PG8_WAIT_V(8); PG8_WAIT_L(0); PG8_BAR; PG8_MMA(0, 0, At, B0); PG8_MMA(0, 1, At, B1); PG8_BAR; PG8_SCHED;
            PG8_LDA(At, 0, 1); PG8_STAGEB(PG8_SB(0, 0), b2); PG8_STAGEB(PG8_SB(0, 1), b2 + hstep); PG8_STAGEA(PG8_SA(0, 0), k2, 0);
            PG8_WAIT_V(8); PG8_WAIT_L(0); PG8_BAR; PG8_MMA(1, 0, At, B0); PG8_MMA(1, 1, At, B1); PG8_BAR; PG8_SCHED;
            PG8_LDB(B0, 1, 0); PG8_LDB(B1, 1, 1); PG8_SCHED; PG8_LDA(At, 1, 0); PG8_STAGEA(PG8_SA(0, 1), k2, 1);
            PG8_WAIT_V(8); PG8_WAIT_L(0); PG8_BAR; PG8_MMA(0, 0, At, B0); PG8_MMA(0, 1, At, B1); PG8_BAR; PG8_SCHED;
            PG8_LDA(At, 1, 1); PG8_STAGEB(PG8_SB(1, 0), b3); PG8_STAGEB(PG8_SB(1, 1), b3 + hstep); PG8_STAGEA(PG8_SA(1, 0), k3, 0);
            PG8_WAIT_V(8); PG8_WAIT_L(0); PG8_BAR; PG8_MMA(1, 0, At, B0); PG8_MMA(1, 1, At, B1); PG8_BAR; PG8_SCHED;
        }
        if (wr == 0) PG8_BAR;
        E(acc, cur, wr, wc, fr, fq);
        if (!has_next) break;
#pragma unroll
        for (int a = 0; a < 2; ++a)
#pragma unroll
            for (int b = 0; b < 2; ++b)
#pragma unroll
                for (int m = 0; m < MT; ++m)
#pragma unroll
                    for (int n = 0; n < 2; ++n) acc[a][b][m][n] = (f32x4){0.f, 0.f, 0.f, 0.f};
        cur = nxt; cB = nB; ++ui;
        if (wr == 1) PG8_BAR;
    }
    PG8_WAIT_V(0);
    PG8_BAR;
#undef PG8_SA
#undef PG8_SB
#undef PG8_STAGEA
#undef PG8_STAGEB
#undef PG8_LDA
#undef PG8_LDB
#undef PG8_MMA
#undef PG8_WAIT_V
#undef PG8_WAIT_L
#undef PG8_BAR
#undef PG8_SCHED
#undef PG8_AOFFS
}

struct DenseSched {
    static constexpr bool GATHER = false;
    const char* Bt; int K, nM, nN, G, c, latent_only, trows;
    __device__ __forceinline__ bool next(int i, GUnit& u) const {
        const int nwg = nM * nN; const long L = (long)i * G + c; if (L >= nwg) return false;
        int wgid = (int)L; { const int q = nwg / NXCD, r = nwg % NXCD, xcd = wgid % NXCD, off = wgid / NXCD; wgid = (xcd < r ? xcd * (q + 1) : r * (q + 1) + (xcd - r) * q) + off; }
        const int nig = WGM * nN, gid = wgid / nig, fm = gid * WGM, gsz = (nM - fm) < WGM ? (nM - fm) : WGM;
        int pm = fm + ((wgid % nig) % gsz); const int pn = (wgid % nig) / gsz;
        if (latent_only) pm = (pm / 8) * 9 + 1 + (pm % 8);
        u.pm = pm; u.pn = pn; u.arow0 = pm * trows; u.B = Bt + (size_t)pn * 256 * K * 2; u.e = 0; u.cnt = 0; u.tb = 0; return true;
    }
    __device__ __forceinline__ int arow(const GUnit& u, int rloc) const { return u.arow0 + rloc; }
    __device__ __forceinline__ bool short_a_round() const { const int nwg = nM * nN, T = nwg % G; return T > 0 && c >= T; }
};
template <bool GATHER_> struct MoeSched {
    static constexpr bool GATHER = GATHER_;
    const char* Wt; size_t wstride; const int* ecnt; const i32x2* elist; int K, nN, G, c; LAS int* tab; int ntile;
    __device__ __forceinline__ void init() {
        if (threadIdx.x == 0) {
            int acc = 0;
            for (int e = 0; e < NE; ++e) { const int cc = __hip_atomic_load(ecnt + e, __ATOMIC_RELAXED, __HIP_MEMORY_SCOPE_AGENT); tab[e] = acc; tab[17 + e] = cc; acc += (cc + 255) / 256; }
            tab[NE] = acc;
        }
        __syncthreads();
        ntile = __builtin_amdgcn_readfirstlane(tab[NE]);
    }
    __device__ __forceinline__ void reuse() { ntile = __builtin_amdgcn_readfirstlane(tab[NE]); }
    __device__ __forceinline__ bool next(int i, GUnit& u) const {
        const int x = c & 7, w = c >> 3, G8 = G >> 3, tb0 = ntile / 8, rem = ntile % 8, ntx = tb0 + (x < rem ? 1 : 0), start = x * tb0 + (x < rem ? x : rem);
        const int v = i * G8 + w; if (v >= ntx * nN) return false;
        const int tile = start + v / nN, pn = v % nN; int e_ = 0;
        for (int e = 1; e < NE; ++e) { if (__builtin_amdgcn_readfirstlane(tab[e]) <= tile) e_ = e; }
        const int tb_ = __builtin_amdgcn_readfirstlane(tab[e_]), cnt_ = __builtin_amdgcn_readfirstlane(tab[17 + e_]);
        u.pm = tile; u.pn = pn; u.e = e_; u.tb = tb_; u.cnt = cnt_ - (tile - tb_) * 256; u.arow0 = tile * 256;
        u.B = Wt + (size_t)e_ * wstride + (size_t)pn * 256 * K * 2; return true;
    }
    __device__ __forceinline__ bool short_a_round() const { const int x = c & 7, w = c >> 3, G8 = G >> 3, tb0 = ntile / 8, rem = ntile % 8, ntx = tb0 + (x < rem ? 1 : 0), T = (ntx * nN) % G8; return T > 0 && w >= T; }
    __device__ __forceinline__ int arow(const GUnit& u, int rloc) const {
        if (!GATHER) return u.arow0 + rloc;
        const int pos = (u.pm - u.tb) * 256 + rloc;
        return rloc < u.cnt ? (elist[(size_t)u.e * MROWS + pos].x >> 1) : 0;
    }
};

#define EPI_ROWS(...) _Pragma("unroll") for (int ai = 0; ai < 2; ++ai) _Pragma("unroll") for (int m = 0; m < MT; ++m) { const int rloc = ai * (32 * MT) + wr * (16 * MT) + m * 16 + fr; __VA_ARGS__ }
__device__ __forceinline__ void store8(bf16* dst, const f32x4 v0, const f32x4 v1) {
    u32x4 w; w.x = cvt_pk_bf16(v0[0], v0[1]); w.y = cvt_pk_bf16(v0[2], v0[3]); w.z = cvt_pk_bf16(v1[0], v1[1]); w.w = cvt_pk_bf16(v1[2], v1[3]); *(u32x4*)dst = w;
}
__device__ __forceinline__ unsigned pk4_f8(const f32x4 v) {
    int w = __builtin_amdgcn_cvt_pk_fp8_f32(__builtin_amdgcn_fmed3f(v[0], -448.0f, 448.0f), __builtin_amdgcn_fmed3f(v[1], -448.0f, 448.0f), 0, false);
    w = __builtin_amdgcn_cvt_pk_fp8_f32(__builtin_amdgcn_fmed3f(v[2], -448.0f, 448.0f), __builtin_amdgcn_fmed3f(v[3], -448.0f, 448.0f), w, true); return (unsigned)w; }
__device__ __forceinline__ void store8_f8(unsigned char* dst, const f32x4 v0, const f32x4 v1) {
    typedef unsigned u32x2_ __attribute__((ext_vector_type(2))); u32x2_ w; w.x = pk4_f8(v0); w.y = pk4_f8(v1); *(u32x2_*)dst = w; }
struct EpiG1M {
    bf16 *Q, *Kb, *V, *O; float* GT; const float* bgate;
    template <int MT> __device__ __forceinline__ void operator()(const f32x4 (&acc)[2][2][MT][2], const GUnit& u, int wr, int wc, int fr, int fq) const {
        const int pn = u.pn;
        if (pn < 12) {
            bf16* base; int ld, colt; float sc = 1.0f; bool sig = false;
            if (pn < 2) { base = Q; ld = QKW; colt = pn * 256; sc = 0.125f; } else if (pn < 4) { base = Kb; ld = QKW; colt = (pn - 2) * 256; }
            else if (pn < 8) { base = V; ld = VW; colt = (pn - 4) * 256; } else { base = O; ld = VW; colt = (pn - 8) * 256; sig = true; }
            const int col0 = colt + wc * 32 + 8 * fq;
            EPI_ROWS(
                bf16* rowp = base + (size_t)(u.arow0 + rloc) * ld + col0;
                _Pragma("unroll") for (int bj = 0; bj < 2; ++bj) { f32x4 v0 = acc[ai][bj][m][0] * sc, v1 = acc[ai][bj][m][1] * sc;
                    if (sig) { _Pragma("unroll") for (int q = 0; q < 4; ++q) { v0[q] = fsigmoid(v0[q]); v1[q] = fsigmoid(v1[q]); } }
                    store8(rowp + bj * 128, v0, v1); }
            )
        } else if (wc == 0) {
            EPI_ROWS(
                float* rowp = GT + (size_t)(u.arow0 + rloc) * 32 + 8 * fq;
                _Pragma("unroll") for (int n = 0; n < 2; ++n) { f32x4 v = acc[ai][0][m][n];
                    _Pragma("unroll") for (int q = 0; q < 4; ++q) { float x = v[q] + bgate[8 * fq + 4 * n + q]; if (fq & 1) x = logsigmoidf_(x); v[q] = x; }
                    *(f32x4*)(rowp + 4 * n) = v; }
            )
        }
    }
};
struct EpiG1R {
    bf16 *GY, *XR;
    template <int MT> __device__ __forceinline__ void operator()(const f32x4 (&acc)[2][2][MT][2], const GUnit& u, int wr, int wc, int fr, int fq) const {
        const int pn = u.pn; const bool act = pn < 4; bf16* base = act ? GY : XR; const int col0 = (act ? pn : pn - 4) * 256 + wc * 32 + 8 * fq;
        EPI_ROWS(
            bf16* rowp = base + (size_t)(u.arow0 + rloc) * D + col0;
            _Pragma("unroll") for (int bj = 0; bj < 2; ++bj) { f32x4 v0 = acc[ai][bj][m][0], v1 = acc[ai][bj][m][1];
                if (act) { _Pragma("unroll") for (int q = 0; q < 4; ++q) {
                    float x = v0[q]; v0[q] = x * fsigmoid(1.5957691216057308f * (x + 0.044715f * x * x * x));
                    x = v1[q]; v1[q] = x * fsigmoid(1.5957691216057308f * (x + 0.044715f * x * x * x)); } }
                store8(rowp + bj * 128, v0, v1); }
        )
    }
};
struct EpiPlain {
    bf16* O; int ld;
    template <int MT> __device__ __forceinline__ void operator()(const f32x4 (&acc)[2][2][MT][2], const GUnit& u, int wr, int wc, int fr, int fq) const {
        const int col0 = u.pn * 256 + wc * 32 + 8 * fq;
        EPI_ROWS(
            bf16* rowp = O + (size_t)(u.arow0 + rloc) * ld + col0;
            _Pragma("unroll") for (int bj = 0; bj < 2; ++bj) store8(rowp + bj * 128, acc[ai][bj][m][0], acc[ai][bj][m][1]);
        )
    }
};
struct EpiG3 {
    bf16* U;
    template <int MT> __device__ __forceinline__ void operator()(const f32x4 (&acc)[2][2][MT][2], const GUnit& u, int wr, int wc, int fr, int fq) const {
        const int col0 = u.pn * 128 + wc * 32 + 8 * fq;
        EPI_ROWS(
            f32x4 v0, v1;
            _Pragma("unroll") for (int q = 0; q < 4; ++q) { const float a0 = acc[ai][0][m][0][q], a1 = acc[ai][0][m][1][q];
                v0[q] = a0 * fsigmoid(a0) * acc[ai][1][m][0][q]; v1[q] = a1 * fsigmoid(a1) * acc[ai][1][m][1][q]; }
            store8(U + (size_t)(u.arow0 + rloc) * DE + col0, v0, v1);
        )
    }
};
struct EpiG4 {
    unsigned char* Y; const i32x2* elist;
    template <int MT> __device__ __forceinline__ void operator()(const f32x4 (&acc)[2][2][MT][2], const GUnit& u, int wr, int wc, int fr, int fq) const {
        const int col0 = u.pn * 256 + wc * 32 + 8 * fq;
        int ent[2][MT]; float tw[2][MT];
        EPI_ROWS( const i32x2 et = rloc < u.cnt ? elist[(size_t)u.e * MROWS + (u.pm - u.tb) * 256 + rloc] : (i32x2){-1, 0}; const int e0_ = et.x, e1_ = et.y; ent[ai][m] = e0_; tw[ai][m] = __builtin_bit_cast(float, e1_); )
        EPI_ROWS(
            if (ent[ai][m] >= 0) { const float t = tw[ai][m];
                u32x4 w; w.x = pk4_f8(acc[ai][0][m][0] * t); w.y = pk4_f8(acc[ai][0][m][1] * t); w.z = pk4_f8(acc[ai][1][m][0] * t); w.w = pk4_f8(acc[ai][1][m][1] * t);
                *(u32x4*)(Y + (size_t)ent[ai][m] * D + u.pn * 256 + wc * 64 + fq * 16) = w; }
        )
    }
};
}

__device__ __forceinline__ bool o_g1(const Params& p, int i, LAS unsigned char* lds) {
    const int j = i >> 1;
    if ((i & 1) == 0) {
        gm::DenseSched S{(const char*)(WSP(bf16, WS_WINM) + (size_t)j * MPROJ_P * D), D, MROWS / 256, MPROJ_P / 256, (int)gridDim.x, (int)blockIdx.x, 0, 256};
        gm::EpiG1M E{WSP(bf16, WS_Q), WSP(bf16, WS_K), WSP(bf16, WS_V), WSP(bf16, WS_O), WSP(float, WS_GT), p.m_b_gate + j * 4 * NH};
        gm::gemm_phase<4>(lds, (const char*)WSP(bf16, WS_HB), D, S, E);
        return S.short_a_round();
    } else {
        gm::DenseSched S{(const char*)(WSP(bf16, WS_WINR) + (size_t)j * 2 * D * D), D, MROWS / 192, 2 * D / 256, (int)gridDim.x, (int)blockIdx.x, 0, 192};
        gm::EpiG1R E{WSP(bf16, WS_GY), WSP(bf16, WS_XR)};
        gm::gemm_phase<3>(lds, (const char*)WSP(bf16, WS_HB), D, S, E);
        return S.short_a_round();
    }
}
__device__ __forceinline__ bool o_g2(const Params& p, int i, LAS unsigned char* lds) {
    const int j = i >> 1; const bool lastl = (i == DEPTH - 1);
    const bf16* W = (i & 1) ? WSP(bf16, WS_WOUTR) + (size_t)j * D * D : WSP(bf16, WS_WOUTM) + (size_t)j * D * VW;
    gm::EpiPlain E{WSP(bf16, WS_HB), D};
    if (lastl) {
        gm::DenseSched S{(const char*)W, RBK, NB * 8, D / 256, (int)gridDim.x, (int)blockIdx.x, 1, 256};
        gm::gemm_phase<4>(lds, (const char*)WSP(bf16, WS_RB), RBK, S, E);
        return S.short_a_round();
    } else {
        gm::DenseSched S{(const char*)W, RBK, MROWS / 192, D / 256, (int)gridDim.x, (int)blockIdx.x, 0, 192};
        gm::gemm_phase<3>(lds, (const char*)WSP(bf16, WS_RB), RBK, S, E);
        return S.short_a_round();
    }
}
__device__ __forceinline__ bool o_g3(const Params& p, int i, LAS unsigned char* lds) {
    gm::MoeSched<true> S{(const char*)(WSP(bf16, WS_W13) + (size_t)i * NE * 2 * DE * D), (size_t)2 * DE * D * 2, WSP(int, WS_CTL) + CW_ECNT + i * NE, WSP(gm::i32x2, WS_ELIST), D, 2 * DE / 256, (int)gridDim.x, (int)blockIdx.x, (LAS int*)(lds + LDS_MISC + 256), 0};
    S.init();
    gm::EpiG3 E{WSP(bf16, WS_U)};
    gm::gemm_phase<4>(lds, (const char*)WSP(bf16, WS_RB), D, S, E);
    return S.short_a_round();
}
__device__ __forceinline__ bool o_g4(const Params& p, int i, LAS unsigned char* lds, const bool have_tab) {
    gm::MoeSched<false> S{(const char*)(WSP(bf16, WS_W2) + (size_t)i * NE * D * DE), (size_t)D * DE * 2, WSP(int, WS_CTL) + CW_ECNT + i * NE, WSP(gm::i32x2, WS_ELIST), DE, D / 256, (int)gridDim.x, (int)blockIdx.x, (LAS int*)(lds + LDS_MISC + 256), 0};
    if (have_tab) S.reuse(); else S.init();
    gm::EpiG4 E{WSP(unsigned char, WS_Y), WSP(gm::i32x2, WS_ELIST)};
    gm::gemm_phase<4>(lds, (const char*)WSP(bf16, WS_U), DE, S, E);
    return S.short_a_round();
}

typedef float f32x4t __attribute__((ext_vector_type(4)));
typedef float f32x2 __attribute__((ext_vector_type(2)));
typedef unsigned u32x2t __attribute__((ext_vector_type(2)));
typedef unsigned u32x4t __attribute__((ext_vector_type(4)));
__device__ __forceinline__ float wave_sum(float v) {
    v += __builtin_bit_cast(float, __builtin_amdgcn_update_dpp(0, __builtin_bit_cast(int, v), 0xB1, 0xF, 0xF, true));
    v += __builtin_bit_cast(float, __builtin_amdgcn_update_dpp(0, __builtin_bit_cast(int, v), 0x4E, 0xF, 0xF, true));
    v += __builtin_bit_cast(float, __builtin_amdgcn_update_dpp(0, __builtin_bit_cast(int, v), 0x141, 0xF, 0xF, true));
    v += __builtin_bit_cast(float, __builtin_amdgcn_update_dpp(0, __builtin_bit_cast(int, v), 0x140, 0xF, 0xF, true));
    const int vi = __builtin_bit_cast(int, v);
    return (__builtin_bit_cast(float, __builtin_amdgcn_readlane(vi, 0)) + __builtin_bit_cast(float, __builtin_amdgcn_readlane(vi, 16))) + (__builtin_bit_cast(float, __builtin_amdgcn_readlane(vi, 32)) + __builtin_bit_cast(float, __builtin_amdgcn_readlane(vi, 48)));
}
__device__ __forceinline__ float rsqrt_nr(float x) { const float y = __builtin_amdgcn_rsqf(x); return y * (1.5f - 0.5f * x * y * y); }
__device__ __forceinline__ f32x4t unpack4(u32x2t w) { return (f32x4t){u2f(w.x << 16), u2f(w.x & 0xFFFF0000u), u2f(w.y << 16), u2f(w.y & 0xFFFF0000u)}; }
__device__ __forceinline__ u32x2t pack4(f32x4t v) { return (u32x2t){gm::cvt_pk_bf16(v[0], v[1]), gm::cvt_pk_bf16(v[2], v[3])}; }
__device__ __forceinline__ f32x4t unpack4_f8(const unsigned w) {
    typedef float f2_t_ __attribute__((ext_vector_type(2)));
    const f2_t_ a = __builtin_amdgcn_cvt_pk_f32_fp8((int)w, false), b = __builtin_amdgcn_cvt_pk_f32_fp8((int)w, true); const float a0 = a[0], a1 = a[1], b0 = b[0], b1 = b[1];
    return (f32x4t){a0, a1, b0, b1}; }
static_assert(MROWS % (256 * 8) == 0 || true, "");
constexpr int ROWS_PER_WAVE = MROWS / (256 * 8);

#ifndef HOST_EMU
__device__ __forceinline__ void route16_fast(const float* lg, const float* b_router, int& e0, int& e1, float& w0, float& w1) {
    float mx = lg[0];
#pragma unroll
    for (int e = 1; e < NE; ++e) mx = lg[e] > mx ? lg[e] : mx;
    float sc[NE]; float sum = 0.f;
#pragma unroll
    for (int e = 0; e < NE; ++e) { sc[e] = __expf(lg[e] - mx); sum += sc[e]; }
    const float inv = __builtin_amdgcn_rcpf(sum);
    float gsbest = -3.0e38f; int be0 = 0, be1 = 1; float bs0 = 0.f, bs1 = 0.f;
#pragma unroll
    for (int g = 0; g < 4; ++g) {
        float m1 = -3.0e38f, m2 = -3.0e38f, s1 = 0.f, s2 = 0.f; int i1 = 0, i2 = 0;
#pragma unroll
        for (int i = 0; i < 4; ++i) {
            const float s = sc[4 * g + i] * inv, v = s + b_router[4 * g + i];
            if (v > m1) { m2 = m1; i2 = i1; s2 = s1; m1 = v; i1 = 4 * g + i; s1 = s; }
            else if (v > m2) { m2 = v; i2 = 4 * g + i; s2 = s; }
        }
        const float gs = m1 + m2;
        if (gs > gsbest) { gsbest = gs; be0 = i1; be1 = i2; bs0 = s1; bs1 = s2; }
    }
    e0 = be0; e1 = be1;
    const float t = 1.0f / (bs0 + bs1);
    w0 = bs0 * t; w1 = bs1 * t;
}
#endif
__device__ __forceinline__ void wave_sum16(float (&v)[NE], int lane) {
    const bool b3 = lane & 8, b2 = lane & 4;
    float r8[8], r4[4], r2[2], r1;
#pragma unroll
    for (int j = 0; j < 8; ++j) { const auto t = __builtin_amdgcn_permlane32_swap(__builtin_bit_cast(unsigned, v[j]), __builtin_bit_cast(unsigned, v[j + 8]), false, false); const unsigned t0 = t[0], t1 = t[1]; r8[j] = __builtin_bit_cast(float, t0) + __builtin_bit_cast(float, t1); }
#pragma unroll
    for (int j = 0; j < 4; ++j) { const auto t = __builtin_amdgcn_permlane16_swap(__builtin_bit_cast(unsigned, r8[j]), __builtin_bit_cast(unsigned, r8[j + 4]), false, false); const unsigned t0 = t[0], t1 = t[1]; r4[j] = __builtin_bit_cast(float, t0) + __builtin_bit_cast(float, t1); }
#pragma unroll
    for (int j = 0; j < 2; ++j) { const float keep = b3 ? r4[j + 2] : r4[j], send = b3 ? r4[j] : r4[j + 2]; r2[j] = keep + __builtin_bit_cast(float, __builtin_amdgcn_update_dpp(0, __builtin_bit_cast(int, send), 0x140, 0xF, 0xF, true)); }
    { const float keep = b2 ? r2[1] : r2[0], send = b2 ? r2[0] : r2[1]; r1 = keep + __builtin_bit_cast(float, __builtin_amdgcn_update_dpp(0, __builtin_bit_cast(int, send), 0x141, 0xF, 0xF, true)); }
    r1 += __builtin_bit_cast(float, __builtin_amdgcn_update_dpp(0, __builtin_bit_cast(int, r1), 0x4E, 0xF, 0xF, true));
    r1 += __builtin_bit_cast(float, __builtin_amdgcn_update_dpp(0, __builtin_bit_cast(int, r1), 0xB1, 0xF, 0xF, true));
#pragma unroll
    for (int e = 0; e < NE; ++e) v[e] = __builtin_bit_cast(float, __builtin_amdgcn_readlane(__builtin_bit_cast(int, r1), ((e >> 3) & 1) * 32 + ((e >> 2) & 1) * 16 + ((e >> 1) & 1) * 8 + (e & 1) * 4));
}
__device__ __forceinline__ float wave_sum16_l(const float (&v)[NE], int lane) {
    const bool b3 = lane & 8, b2 = lane & 4;
    float r8[8], r4[4], r2[2], r1;
#pragma unroll
    for (int j = 0; j < 8; ++j) { const auto t = __builtin_amdgcn_permlane32_swap(__builtin_bit_cast(unsigned, v[j]), __builtin_bit_cast(unsigned, v[j + 8]), false, false); const unsigned t0 = t[0], t1 = t[1]; r8[j] = __builtin_bit_cast(float, t0) + __builtin_bit_cast(float, t1); }
#pragma unroll
    for (int j = 0; j < 4; ++j) { const auto t = __builtin_amdgcn_permlane16_swap(__builtin_bit_cast(unsigned, r8[j]), __builtin_bit_cast(unsigned, r8[j + 4]), false, false); const unsigned t0 = t[0], t1 = t[1]; r4[j] = __builtin_bit_cast(float, t0) + __builtin_bit_cast(float, t1); }
#pragma unroll
    for (int j = 0; j < 2; ++j) { const float keep = b3 ? r4[j + 2] : r4[j], send = b3 ? r4[j] : r4[j + 2]; r2[j] = keep + __builtin_bit_cast(float, __builtin_amdgcn_update_dpp(0, __builtin_bit_cast(int, send), 0x140, 0xF, 0xF, true)); }
    { const float keep = b2 ? r2[1] : r2[0], send = b2 ? r2[0] : r2[1]; r1 = keep + __builtin_bit_cast(float, __builtin_amdgcn_update_dpp(0, __builtin_bit_cast(int, send), 0x141, 0xF, 0xF, true)); }
    r1 += __builtin_bit_cast(float, __builtin_amdgcn_update_dpp(0, __builtin_bit_cast(int, r1), 0x4E, 0xF, 0xF, true));
    r1 += __builtin_bit_cast(float, __builtin_amdgcn_update_dpp(0, __builtin_bit_cast(int, r1), 0xB1, 0xF, 0xF, true));
    return r1;
}
#define DPPF_(x, c) __builtin_bit_cast(float, __builtin_amdgcn_update_dpp(0, __builtin_bit_cast(int, (x)), (c), 0xF, 0xF, true))
#define DPPI_(x, c) __builtin_amdgcn_update_dpp(0, (x), (c), 0xF, 0xF, true)
#define RLF_(x, l) __builtin_bit_cast(float, __builtin_amdgcn_readlane(__builtin_bit_cast(int, (x)), (l)))
__device__ __forceinline__ void route16_l(const float lgv, const int lane, const float mybias, int& e0, int& e1, float& w0, float& w1) {
    const int e = lane >> 2;
    float m = fmaxf(lgv, DPPF_(lgv, 0x141)); m = fmaxf(m, DPPF_(m, 0x140));
    const float mx = fmaxf(fmaxf(RLF_(m, 0), RLF_(m, 16)), fmaxf(RLF_(m, 32), RLF_(m, 48)));
    const float sc = __expf(lgv - mx);
    float rs = sc + DPPF_(sc, 0x141); rs += DPPF_(rs, 0x140);
    const float sum = (RLF_(rs, 0) + RLF_(rs, 16)) + (RLF_(rs, 32) + RLF_(rs, 48));
    const float s = sc * __builtin_amdgcn_rcpf(sum), v = s + mybias;
    float m1 = fmaxf(v, DPPF_(v, 0x141)); m1 = fmaxf(m1, DPPF_(m1, 0x140));
    int c1 = v == m1 ? e : 99; { const int t = DPPI_(c1, 0x141); c1 = t < c1 ? t : c1; } { const int t = DPPI_(c1, 0x140); c1 = t < c1 ? t : c1; }
    const float v2 = e == c1 ? -3.0e38f : v;
    float m2 = fmaxf(v2, DPPF_(v2, 0x141)); m2 = fmaxf(m2, DPPF_(m2, 0x140));
    int c2 = v2 == m2 ? e : 99; { const int t = DPPI_(c2, 0x141); c2 = t < c2 ? t : c2; } { const int t = DPPI_(c2, 0x140); c2 = t < c2 ? t : c2; }
    const float gs = m1 + m2;
    const float g0 = RLF_(gs, 0), g1 = RLF_(gs, 16), g2 = RLF_(gs, 32), g3 = RLF_(gs, 48);
    int gb = 0; float gbest = g0; if (g1 > gbest) { gbest = g1; gb = 1; } if (g2 > gbest) { gbest = g2; gb = 2; } if (g3 > gbest) { gb = 3; }
    const int gbu = __builtin_amdgcn_readfirstlane(gb);
    e0 = __builtin_amdgcn_readlane(c1, gbu * 16); e1 = __builtin_amdgcn_readlane(c2, gbu * 16);
    const float bs0 = RLF_(s, e0 * 4), bs1 = RLF_(s, e1 * 4);
    const float t = 1.0f / (bs0 + bs1);
    w0 = bs0 * t; w1 = bs1 * t;
}
#undef DPPF_
#undef DPPI_
#undef RLF_
__device__ __forceinline__ void o_t1_edge(const Params& p, const int i) {
    int tid_ = threadIdx.x; asm volatile("" : "+v"(tid_));
    const int wid = tid_ >> 6, lane = tid_ & 63, gw = blockIdx.x * 8 + wid;
    bf16* X = WSP(bf16, WS_X); bf16* HB = WSP(bf16, WS_HB); const unsigned char* Y = WSP(unsigned char, WS_Y); const float* MOD = WSP(float, WS_MOD);
    int cur_bp = -1; f32x4t gs[4], sh[4], g5[4], g2p[4];
    float pf[4];
#pragma unroll
    for (int jj = 0; jj < 4; ++jj) pf[jj] = __expf(-9.210340371976184f * (float)(lane * 4 + jj) * (1.0f / (float)(D / 4)));
    for (int rr = 0; rr < ROWS_PER_WAVE; ++rr) {
        const int r = gw * ROWS_PER_WAVE + rr; if (r >= MROWS) break;
        const int b = r / S, s = r % S; const bool isctx = s < CTX; const int bp = isctx ? NB : b;
        if (i == DEPTH && isctx) continue;
        if (bp != cur_bp) {
            cur_bp = bp;
#pragma unroll
            for (int q = 0; q < 4; ++q) { const int k = q * 256 + lane * 4;
                if (i < DEPTH) { const float* mod = MOD + ((size_t)i * (NB + 1) + bp) * 6 * D; const f32x4t gm4 = *(const f32x4t*)(p.g_mix + i * D + k), sc4 = *(const f32x4t*)(mod + D + k);
                    sh[q] = *(const f32x4t*)(mod + k); gs[q] = gm4 * (sc4 + 1.0f); }
                else { gs[q] = *(const f32x4t*)(p.g_final + k); sh[q] = (f32x4t){0.f, 0.f, 0.f, 0.f}; }
                if (i > 0) { g5[q] = *(const f32x4t*)(MOD + ((size_t)(i - 1) * (NB + 1) + bp) * 6 * D + 5 * D + k); g2p[q] = *(const f32x4t*)(MOD + ((size_t)(i - 1) * (NB + 1) + bp) * 6 * D + 2 * D + k); } }
        }
        f32x4t v[4]; float ss = 0.f;
#pragma unroll
        for (int q = 0; q < 4; ++q) { const int k = q * 256 + lane * 4;
            if (i == 0) {
                const float* src = isctx ? p.ctx + ((size_t)b * CTX + s) * D : p.x + ((size_t)b * SEQ + (s - CTX)) * D;
                v[q] = __builtin_nontemporal_load((const f32x4t*)(src + k));
            } else {
                const int yp_ = q * 256 + (((lane * 4) & 127) >> 3) * 16 + ((lane * 4) >> 7) * 8 + ((lane * 4) & 7);
                const unsigned yw0 = *(const unsigned*)(Y + ((size_t)r * 2 + 0) * D + yp_), yw1 = *(const unsigned*)(Y + ((size_t)r * 2 + 1) * D + yp_);
                const f32x4t y0 = unpack4_f8(yw0), y1 = unpack4_f8(yw1);
                v[q] = unpack4(*(const u32x2t*)(X + (size_t)r * D + k)) + g2p[q] * unpack4(*(const u32x2t*)(HB + (size_t)r * D + k)) + g5[q] * (y0 + y1);
            }
        }
        if (i == 0 && !isctx) { const int t_ = s - CTX; const float gr_ = (float)(t_ / GRIDW), gc_ = (float)(t_ % GRIDW);
#pragma unroll
            for (int jj = 0; jj < 4; ++jj) { const float ar = gr_ * pf[jj], ac = gc_ * pf[jj]; v[0][jj] += __sinf(ar); v[1][jj] += __cosf(ar); v[2][jj] += __sinf(ac); v[3][jj] += __cosf(ac); } }
#pragma unroll
        for (int q = 0; q < 4; ++q) ss += v[q][0] * v[q][0] + v[q][1] * v[q][1] + v[q][2] * v[q][2] + v[q][3] * v[q][3];
        ss = wave_sum(ss);
        const float rstd = rsqrt_nr(ss * (1.0f / (float)D) + EPS);
#pragma unroll
        for (int q = 0; q < 4; ++q) { const int k = q * 256 + lane * 4;
            if (i == DEPTH) __builtin_nontemporal_store(v[q] * rstd * gs[q], (f32x4t*)(p.out + ((size_t)b * SEQ + (s - CTX)) * D + k));
            else { *(u32x2t*)(X + (size_t)r * D + k) = pack4(v[q]); *(u32x2t*)(HB + (size_t)r * D + k) = pack4(v[q] * rstd * gs[q] + sh[q]); }
        }
    }
}

#define TK(q) (((q) >> 1) * 512 + lane * 8 + ((q) & 1) * 4)
__device__ __forceinline__ void unpack8(const u32x4t w, f32x4t& lo, f32x4t& hi) { lo = unpack4((u32x2t){w.x, w.y}); hi = unpack4((u32x2t){w.z, w.w}); }
__device__ __forceinline__ u32x4t pack8(const f32x4t lo, const f32x4t hi) { const u32x2t a = pack4(lo), b = pack4(hi); return (u32x4t){a.x, a.y, b.x, b.y}; }
#undef TK
#define TK(q) ((lane >> 4) * 256 + ((q) >> 1) * 128 + (lane & 15) * 8 + ((q) & 1) * 4)
__device__ __forceinline__ void o_t1_mid(const Params& p, const int i) {
    int tid_ = threadIdx.x; asm volatile("" : "+v"(tid_));
    const int wid = tid_ >> 6, lane = tid_ & 63, gw = blockIdx.x * 8 + wid;
    bf16* X = WSP(bf16, WS_X); bf16* HB = WSP(bf16, WS_HB); const unsigned char* Y = WSP(unsigned char, WS_Y); const float* MOD = WSP(float, WS_MOD);
    int cur_bp = -1; f32x4t gs[4], sh[4], g5[4], g2p[4];
    for (int rr = 0; rr < ROWS_PER_WAVE; ++rr) {
        const int r = gw * ROWS_PER_WAVE + rr;
        const int b = r / S, s = r % S; const bool isctx = s < CTX; const int bp = isctx ? NB : b;
        if (bp != cur_bp) {
            cur_bp = bp; const float* mod = MOD + ((size_t)i * (NB + 1) + bp) * 6 * D; const float* modp = MOD + ((size_t)(i - 1) * (NB + 1) + bp) * 6 * D;
#pragma unroll
            for (int q = 0; q < 4; ++q) { const int k = TK(q); const f32x4t gm4 = *(const f32x4t*)(p.g_mix + i * D + k), sc4 = *(const f32x4t*)(mod + D + k);
                sh[q] = *(const f32x4t*)(mod + k); gs[q] = gm4 * (sc4 + 1.0f); g5[q] = *(const f32x4t*)(modp + 5 * D + k); g2p[q] = *(const f32x4t*)(modp + 2 * D + k); }
        }
        f32x4t v[4]; float ss = 0.f;
        const u32x4t yA = *(const u32x4t*)(Y + ((size_t)r * 2 + 0) * D + (lane >> 4) * 256 + (lane & 15) * 16), yB = *(const u32x4t*)(Y + ((size_t)r * 2 + 1) * D + (lane >> 4) * 256 + (lane & 15) * 16);
#pragma unroll
        for (int h = 0; h < 2; ++h) { const int k0 = TK(2 * h);
            const u32x4t xw = __builtin_nontemporal_load((const u32x4t*)(X + (size_t)r * D + k0)), ow = *(const u32x4t*)(HB + (size_t)r * D + k0);
            const unsigned ya0 = h ? yA.z : yA.x, ya1 = h ? yA.w : yA.y, yb0 = h ? yB.z : yB.x, yb1 = h ? yB.w : yB.y;
            f32x4t x0, x1, o0, o1; unpack8(xw, x0, x1); unpack8(ow, o0, o1); const f32x4t a0 = unpack4_f8(ya0), a1 = unpack4_f8(ya1), b0 = unpack4_f8(yb0), b1 = unpack4_f8(yb1);
            v[2 * h] = x0 + g2p[2 * h] * o0 + g5[2 * h] * (a0 + b0); v[2 * h + 1] = x1 + g2p[2 * h + 1] * o1 + g5[2 * h + 1] * (a1 + b1); }
#pragma unroll
        for (int q = 0; q < 4; ++q) ss += v[q][0] * v[q][0] + v[q][1] * v[q][1] + v[q][2] * v[q][2] + v[q][3] * v[q][3];
        ss = wave_sum(ss);
        const float rstd = rsqrt_nr(ss * (1.0f / (float)D) + EPS);
#pragma unroll
        for (int h = 0; h < 2; ++h) { const int k0 = TK(2 * h);
            *(u32x4t*)(X + (size_t)r * D + k0) = pack8(v[2 * h], v[2 * h + 1]);
            *(u32x4t*)(HB + (size_t)r * D + k0) = pack8(v[2 * h] * rstd * gs[2 * h] + sh[2 * h], v[2 * h + 1] * rstd * gs[2 * h + 1] + sh[2 * h + 1]); }
    }
}
#undef TK
#define TK(q) (((q) >> 1) * 512 + lane * 8 + ((q) & 1) * 4)
__device__ __forceinline__ void o_t1(const Params& p, const int i) { if (i == 0 || i == DEPTH) o_t1_edge(p, i); else o_t1_mid(p, i); }

constexpr int T2_WT = 0, T2_TAB = 65536;
__device__ __forceinline__ void o_t2(const Params& p, const int i, LAS unsigned char* lds) {
    int tid_ = threadIdx.x; asm volatile("" : "+v"(tid_));
    const int tid = tid_, wid = tid >> 6, lane = tid & 63, gw = blockIdx.x * 8 + wid;
    const bf16* X = WSP(bf16, WS_X); const bf16* HB = WSP(bf16, WS_HB); bf16* RB = WSP(bf16, WS_RB); const float* MOD = WSP(float, WS_MOD);
    gm::i32x2* EL = WSP(gm::i32x2, WS_ELIST); int* ECNT = WSP(int, WS_CTL) + CW_ECNT + i * NE;
    LAS float* WT = (LAS float*)(lds + T2_WT); LAS int* cnt = (LAS int*)(lds + T2_TAB); LAS int* base = cnt + 16; LAS int* ent = cnt + 32; LAS float* entw = (LAS float*)(ent + 8 * ROWS_PER_WAVE * 2);
    u32x4t nxw[2], now_[2];
#define T2_LOAD(r_) do { _Pragma("unroll") for (int h = 0; h < 2; ++h) { nxw[h] = __builtin_nontemporal_load((const u32x4t*)(X + (size_t)(r_) * D + TK(2 * h))); now_[h] = *(const u32x4t*)(HB + (size_t)(r_) * D + TK(2 * h)); } } while (0)
    T2_LOAD(gw * ROWS_PER_WAVE);
    int cur_bp; f32x4t gs[4], sh[4], g2[4];
    { const int r0_ = gw * ROWS_PER_WAVE; cur_bp = (r0_ % S) < CTX ? NB : r0_ / S; const float* mod = MOD + ((size_t)i * (NB + 1) + cur_bp) * 6 * D;
#pragma unroll
        for (int q = 0; q < 4; ++q) { const int k = TK(q); const f32x4t gm4 = *(const f32x4t*)(p.g_ffn + i * D + k), sc4 = *(const f32x4t*)(mod + 4 * D + k);
            sh[q] = *(const f32x4t*)(mod + 3 * D + k); gs[q] = gm4 * (sc4 + 1.0f); g2[q] = *(const f32x4t*)(mod + 2 * D + k); } }
    const float mybias = p.b_router[lane >> 2];
    for (int it = tid; it < D * NE / 4; it += 512) { const int k = it >> 2, e4 = (it & 3) * 4; const f32x4t w = *(const f32x4t*)(p.w_router + k * NE + e4);
        const int q_ = ((k >> 9) << 1) | ((k >> 2) & 1), ln_ = (k & 511) >> 3, idx = (q_ * 64 + ln_) * 4 + (k & 3);
        WT[(e4 + 0) * D + idx] = w[0]; WT[(e4 + 1) * D + idx] = w[1]; WT[(e4 + 2) * D + idx] = w[2]; WT[(e4 + 3) * D + idx] = w[3]; }
    if (tid < 16) cnt[tid] = 0;
    __syncthreads();
    for (int rr = 0; rr < ROWS_PER_WAVE; ++rr) {
        const int r = gw * ROWS_PER_WAVE + rr, rl = wid * ROWS_PER_WAVE + rr;
        u32x4t cxw[2], cow[2];
#pragma unroll
        for (int h = 0; h < 2; ++h) { cxw[h] = nxw[h]; cow[h] = now_[h]; }
        if (rr + 1 < ROWS_PER_WAVE) T2_LOAD(r + 1);
        const int b = r / S, s = r % S; const bool isctx = s < CTX; const int bp = isctx ? NB : b;
        if (i == DEPTH - 1 && isctx) { if (lane == 0) { int m1 = -1; asm volatile("" : "+v"(m1)); ent[rl * 2] = m1; ent[rl * 2 + 1] = m1; } continue; }
        if (bp != cur_bp) {
            cur_bp = bp; const float* mod = MOD + ((size_t)i * (NB + 1) + bp) * 6 * D;
#pragma unroll
            for (int q = 0; q < 4; ++q) { const int k = TK(q); const f32x4t gm4 = *(const f32x4t*)(p.g_ffn + i * D + k), sc4 = *(const f32x4t*)(mod + 4 * D + k);
                sh[q] = *(const f32x4t*)(mod + 3 * D + k); gs[q] = gm4 * (sc4 + 1.0f); g2[q] = *(const f32x4t*)(mod + 2 * D + k); }
        }
        f32x4t v[4]; float ss = 0.f;
#pragma unroll
        for (int h = 0; h < 2; ++h) {
            f32x4t x0, x1, o0, o1; unpack8(cxw[h], x0, x1); unpack8(cow[h], o0, o1);
            v[2 * h] = x0 + g2[2 * h] * o0; v[2 * h + 1] = x1 + g2[2 * h + 1] * o1; }
#pragma unroll
        for (int q = 0; q < 4; ++q) ss += v[q][0] * v[q][0] + v[q][1] * v[q][1] + v[q][2] * v[q][2] + v[q][3] * v[q][3];
        ss = wave_sum(ss);
        const float rstd = rsqrt_nr(ss * (1.0f / (float)D) + EPS);
        f32x2 lg2[NE];
#pragma unroll
        for (int e = 0; e < NE; ++e) lg2[e] = (f32x2){0.f, 0.f};
#pragma unroll
        for (int q = 0; q < 4; ++q) v[q] = v[q] * rstd * gs[q] + sh[q];
#pragma unroll
        for (int h = 0; h < 2; ++h) *(u32x4t*)(RB + (size_t)r * RBK + TK(2 * h)) = pack8(v[2 * h], v[2 * h + 1]);
#pragma unroll
        for (int q = 0; q < 4; ++q) { const f32x4t h = v[q];
            f32x4t wv[NE];
#pragma unroll
            for (int e = 0; e < NE; ++e) wv[e] = *(const LAS f32x4t*)(WT + e * D + (q * 64 + lane) * 4);
            asm volatile("" ::: "memory");
#pragma unroll
            for (int e = 0; e < NE; ++e) { lg2[e] = (f32x2){h[0], h[1]} * (f32x2){wv[e][0], wv[e][1]} + lg2[e]; lg2[e] = (f32x2){h[2], h[3]} * (f32x2){wv[e][2], wv[e][3]} + lg2[e]; }
        }
        float lg[NE];
#pragma unroll
        for (int e = 0; e < NE; ++e) lg[e] = lg2[e][0] + lg2[e][1];
        const float lgv = wave_sum16_l(lg, lane);
        int e0, e1; float w0, w1; route16_l(lgv, lane, mybias, e0, e1, w0, w1);
        if (lane == 0) { ent[rl * 2] = e0; ent[rl * 2 + 1] = e1; entw[rl * 2] = w0; entw[rl * 2 + 1] = w1; }
    }
#undef T2_LOAD
    if (lane < ROWS_PER_WAVE * 2) { const int idx = wid * ROWS_PER_WAVE * 2 + lane; const int en = ent[idx];
        if (en >= 0) { const int k = __hip_atomic_fetch_add(cnt + en, 1, __ATOMIC_RELAXED, __HIP_MEMORY_SCOPE_WORKGROUP); ent[idx] = en | (k << 8); } }
    __syncthreads();
    if (tid < 16) base[tid] = atomicAdd(ECNT + tid, (int)cnt[tid]);
    __syncthreads();
    if (tid < 8 * ROWS_PER_WAVE * 2) {
        const int en = ent[tid];
        if (en >= 0) { const int e = en & 255, k = en >> 8, rl = tid >> 1, r = (blockIdx.x * 8 + rl / ROWS_PER_WAVE) * ROWS_PER_WAVE + rl % ROWS_PER_WAVE;
            EL[(size_t)e * MROWS + base[e] + k] = (gm::i32x2){r * 2 + (tid & 1), __builtin_bit_cast(int, entw[tid])}; }
    }
    __syncthreads();
}

constexpr int P0_MODU = DEPTH * 6 * D / 32;
constexpr int P0_TA = 2 * (D / 64) * (MPROJ_P / 256), P0_TB = 2 * (VW / 64) * (D / 256), P0_TC = 2 * (D / 64) * (2 * D / 256), P0_TD = 2 * (D / 64) * (D / 256), P0_TE = 32 * (RBW / 64),
              P0_TF = DEPTH * NE * (D / 64) * (DE / 256), P0_TH = DEPTH * NE * (DE / 64) * (D / 256);
constexpr int P0_TILES = P0_TA + P0_TB + P0_TC + P0_TD + P0_TE + 2 * P0_TF + P0_TH;
constexpr int P0_TS = 260;
constexpr int P0_SIL = 73728;
struct TileJob { const float* src; bf16* dst; int N, K, k0, n0, kind; };
__device__ __forceinline__ TileJob tile_job(const Params& p, int t) {
    TileJob J; int kt, nt; J.kind = 0;
    if (t < P0_TA) { const int per = P0_TA / 2, j = t / per, rem = t % per; kt = rem / (MPROJ_P / 256); nt = rem % (MPROJ_P / 256); J.src = p.m_w_in + (size_t)j * D * MPROJ; J.N = MPROJ; J.dst = WSP(bf16, WS_WINM) + (size_t)j * MPROJ_P * D; J.K = D; }
    else if ((t -= P0_TA) < P0_TB) { const int per = P0_TB / 2, j = t / per, rem = t % per; kt = rem / (D / 256); nt = rem % (D / 256); J.src = p.m_w_out + (size_t)j * VW * D; J.N = D; J.dst = WSP(bf16, WS_WOUTM) + (size_t)j * D * VW; J.K = VW; }
    else if ((t -= P0_TB) < P0_TC) { const int per = P0_TC / 2, j = t / per, rem = t % per; kt = rem / (2 * D / 256); nt = rem % (2 * D / 256); J.src = p.r_w_in + (size_t)j * D * 2 * D; J.N = 2 * D; J.dst = WSP(bf16, WS_WINR) + (size_t)j * 2 * D * D; J.K = D; }
    else if ((t -= P0_TC) < P0_TD) { const int per = P0_TD / 2, j = t / per, rem = t % per; kt = rem / (D / 256); nt = rem % (D / 256); J.src = p.r_w_out + (size_t)j * D * D; J.N = D; J.dst = WSP(bf16, WS_WOUTR) + (size_t)j * D * D; J.K = D; }
    else if ((t -= P0_TD) < P0_TE) { const int mi = t / (RBW / 64); kt = t % (RBW / 64); nt = 0; J.src = p.r_w_gate + (size_t)mi * RBW * 2 * RBW; J.N = 2 * RBW; J.dst = WSP(bf16, WS_WG) + (size_t)mi * 2 * RBW * RBW; J.K = RBW; }
    else if ((t -= P0_TE) < 2 * P0_TF) { const int w3 = t >= P0_TF; if (w3) t -= P0_TF; const int per = (D / 64) * (DE / 256), ie = t / per, rem = t % per; kt = rem / (DE / 256); nt = rem % (DE / 256);
        J.src = (w3 ? p.e_w3 : p.e_w1) + (size_t)ie * D * DE; J.N = DE; J.dst = WSP(bf16, WS_W13) + (size_t)ie * 2 * DE * D; J.K = D; J.kind = 1 + w3; }
    else { t -= 2 * P0_TF; const int per = (DE / 64) * (D / 256), ie = t / per, rem = t % per; kt = rem / (D / 256); nt = rem % (D / 256); J.src = p.e_w2 + (size_t)ie * DE * D; J.N = D; J.dst = WSP(bf16, WS_W2) + (size_t)ie * D * DE; J.K = DE; }
    J.k0 = kt * 64; J.n0 = nt * 256; return J;
}
__device__ __forceinline__ void tile_load(const TileJob& J, int tid, f32x4t (&v)[8]) {
#pragma unroll
    for (int it = 0; it < 8; ++it) { const int k = it * 8 + (tid >> 6), n = J.n0 + (tid & 63) * 4; v[it] = (f32x4t){0.f, 0.f, 0.f, 0.f};
        if (n + 3 < J.N) v[it] = *(const f32x4t*)(J.src + (size_t)(J.k0 + k) * J.N + n); }
}
constexpr int P0_DENSE = P0_TA + P0_TB + P0_TC + P0_TD + P0_TE, P0_LAYER_E = 3 * NE * 32, P0_NOW = P0_DENSE + P0_LAYER_E, P0_DEFER = (DEPTH - 1) * P0_LAYER_E;
static_assert(P0_TF == DEPTH * NE * 32 && P0_TH == DEPTH * NE * 32 && P0_TILES == P0_DENSE + 3 * P0_TF, "");
constexpr int CW_FILLQ = 20480;
__device__ __forceinline__ int expert_tile(int L, int d) { const int kind = d / (NE * 32), r = d % (NE * 32); return P0_DENSE + kind * P0_TF + L * (NE * 32) + r; }
__device__ __forceinline__ int p0_tile(int j) { return j < P0_DENSE ? j : expert_tile(0, j - P0_DENSE); }
__device__ __forceinline__ void tile_load_nt(const TileJob& J, int tid, f32x4t (&v)[8]) {
#pragma unroll
    for (int it = 0; it < 8; ++it) { const int k = it * 8 + (tid >> 6), n = J.n0 + (tid & 63) * 4; v[it] = (f32x4t){0.f, 0.f, 0.f, 0.f};
        if (n + 3 < J.N) v[it] = __builtin_nontemporal_load((const f32x4t*)(J.src + (size_t)(J.k0 + k) * J.N + n)); }
}
__device__ __forceinline__ int defer_tile(int t) { return expert_tile(1 + t / P0_LAYER_E, t % P0_LAYER_E); }
__device__ __forceinline__ void convert_run(const Params& p, LAS unsigned char* lds, const int t0, const int n, const int tid) {
    LAS float* T = (LAS float*)lds;
    TileJob Ja = tile_job(p, defer_tile(t0)), Jb = Ja; f32x4t va_[8], vb_[8]; tile_load_nt(Ja, tid, va_);
    if (n > 1) { Jb = tile_job(p, defer_tile(t0 + 1)); tile_load_nt(Jb, tid, vb_); }
#define CV_STEP(Jc_, vc_, nk_) do { \
        _Pragma("unroll") for (int it = 0; it < 8; ++it) *(LAS f32x4t*)(T + (it * 8 + (tid >> 6)) * P0_TS + (((tid & 63) ^ it) * 4)) = vc_[it]; \
        __syncthreads(); \
        const TileJob Jd = Jc_; \
        if ((nk_) < n) { Jc_ = tile_job(p, defer_tile(t0 + (nk_))); tile_load_nt(Jc_, tid, vc_); } \
        _Pragma("unroll") for (int it = 0; it < 4; ++it) { const int item = it * 512 + tid, kg = item & 7, nn = item >> 3; \
            float f[8]; \
            _Pragma("unroll") for (int jj = 0; jj < 8; ++jj) f[jj] = T[(kg * 8 + jj) * P0_TS + (nn ^ (kg << 2))]; \
            const int ng = Jd.n0 + nn; const int drow = Jd.kind == 0 ? ng : (ng / 128) * 256 + (Jd.kind - 1) * 128 + ng % 128; \
            u32x4t w; w.x = gm::cvt_pk_bf16(f[0], f[1]); w.y = gm::cvt_pk_bf16(f[2], f[3]); w.z = gm::cvt_pk_bf16(f[4], f[5]); w.w = gm::cvt_pk_bf16(f[6], f[7]); \
            __builtin_nontemporal_store(w, (u32x4t*)(Jd.dst + (size_t)drow * Jd.K + Jd.k0 + kg * 8)); } \
        __syncthreads(); } while (0)
    for (int k = 0; k < n; k += 2) {
        CV_STEP(Ja, va_, k + 2);
        if (k + 1 >= n) break;
        CV_STEP(Jb, vb_, k + 3);
    }
#undef CV_STEP
}
__device__ __forceinline__ void fill_tiles(const Params& p, LAS unsigned char* lds, const int batch, const int limit, const bool repeat) {
    int tid_ = threadIdx.x; asm volatile("" : "+v"(tid_));
    const int tid = tid_;
    int* q = WSP(int, WS_CTL) + CW_FILLQ; volatile LAS int* tk = (volatile LAS int*)(lds + LDS_MISC + 64);
    for (;;) {
        if (tid == 0) { int t = -1; if (!repeat || __hip_atomic_load(q, __ATOMIC_RELAXED, __HIP_MEMORY_SCOPE_AGENT) < limit) t = __hip_atomic_fetch_add(q, batch, __ATOMIC_RELAXED, __HIP_MEMORY_SCOPE_AGENT); *tk = t; }
        __syncthreads();
        const int t = *tk;
        __syncthreads();
        if (t < 0 || t >= P0_DEFER) break;
        convert_run(p, lds, t, (P0_DEFER - t) < batch ? (P0_DEFER - t) : batch, tid);
        if (!repeat) break;
    }
}
__device__ __forceinline__ void o_p0(const Params& p, LAS unsigned char* lds) {
    int tid_ = threadIdx.x; asm volatile("" : "+v"(tid_));
    const int tid = tid_;
    LAS float* T = (LAS float*)lds; LAS float* SIL = (LAS float*)(lds + P0_SIL); LAS float* RED = SIL + (NB + 1) * D;
    for (int it = tid; it < (NB + 1) * D; it += 512) { const int bp = it / D, k = it % D; SIL[it] = siluf_(bp < NB ? p.c[bp * D + k] : p.c_ctx[k]); }
    __syncthreads();
    float* MOD = WSP(float, WS_MOD);
    for (int job = blockIdx.x; job < P0_MODU; job += gridDim.x) {
        const int i = job / (6 * D / 32), n0 = (job % (6 * D / 32)) * 32, col = tid & 31, ks = tid >> 5;
        float acc[NB + 1];
#pragma unroll
        for (int bp = 0; bp <= NB; ++bp) acc[bp] = 0.f;
        const float* w = p.w_ada + (size_t)i * D * 6 * D + n0 + col;
        float wv[64];
#pragma unroll
        for (int k = 0; k < 64; ++k) wv[k] = __builtin_nontemporal_load(w + (size_t)(ks * 64 + k) * 6 * D);
#pragma unroll
        for (int k4 = 0; k4 < 16; ++k4) {
#pragma unroll
            for (int bp = 0; bp <= NB; ++bp) { const f32x4t s4 = *(const LAS f32x4t*)(SIL + bp * D + ks * 64 + 4 * k4);
                acc[bp] = fmaf(s4[3], wv[4 * k4 + 3], fmaf(s4[2], wv[4 * k4 + 2], fmaf(s4[1], wv[4 * k4 + 1], fmaf(s4[0], wv[4 * k4], acc[bp])))); } }
#pragma unroll
        for (int bp = 0; bp <= NB; ++bp) RED[(ks * (NB + 1) + bp) * 32 + col] = acc[bp];
        __syncthreads();
        if (tid < (NB + 1) * 32) { const int bp = tid / 32, c2 = tid % 32; float sum = p.b_ada[i * 6 * D + n0 + c2];
#pragma unroll
            for (int q = 0; q < 16; ++q) sum += RED[(q * (NB + 1) + bp) * 32 + c2];
            MOD[((size_t)i * (NB + 1) + bp) * 6 * D + n0 + c2] = sum; }
        __syncthreads();
    }
    int job = blockIdx.x; if (job >= P0_NOW) return;
    const int stride = (int)gridDim.x;
    TileJob Ja = tile_job(p, p0_tile(job)), Jb = Ja; f32x4t va_[8], vb_[8]; tile_load_nt(Ja, tid, va_);
    bool hasb = job + stride < P0_NOW; if (hasb) { Jb = tile_job(p, p0_tile(job + stride)); tile_load_nt(Jb, tid, vb_); }
#define P0_STEP(Jc_, vc_, nextjob_) do { \
        _Pragma("unroll") for (int it = 0; it < 8; ++it) *(LAS f32x4t*)(T + (it * 8 + (tid >> 6)) * P0_TS + (((tid & 63) ^ it) * 4)) = vc_[it];        \
        __syncthreads(); \
        const TileJob Jd = Jc_; const bool more_ = (nextjob_) < P0_NOW; \
        if (more_) { Jc_ = tile_job(p, p0_tile(nextjob_)); tile_load_nt(Jc_, tid, vc_); } \
        _Pragma("unroll") for (int it = 0; it < 4; ++it) { const int item = it * 512 + tid, kg = item & 7, n = item >> 3; \
            float f[8]; \
            _Pragma("unroll") for (int jj = 0; jj < 8; ++jj) f[jj] = T[(kg * 8 + jj) * P0_TS + (n ^ (kg << 2))]; \
            const int ng = Jd.n0 + n; const int drow = Jd.kind == 0 ? ng : (ng / 128) * 256 + (Jd.kind - 1) * 128 + ng % 128; \
            u32x4t w; w.x = gm::cvt_pk_bf16(f[0], f[1]); w.y = gm::cvt_pk_bf16(f[2], f[3]); w.z = gm::cvt_pk_bf16(f[4], f[5]); w.w = gm::cvt_pk_bf16(f[6], f[7]); \
            *(u32x4t*)(Jd.dst + (size_t)drow * Jd.K + Jd.k0 + kg * 8) = w; } \
        __syncthreads(); } while (0)
    for (;;) {
        P0_STEP(Ja, va_, job + 2 * stride);
        if (job + stride >= P0_NOW) break;
        P0_STEP(Jb, vb_, job + 3 * stride);
        if (job + 2 * stride >= P0_NOW) break;
        job += 2 * stride;
    }
#undef P0_STEP
}

typedef short bf16x8t __attribute__((ext_vector_type(8)));
template <int CTRL> __device__ __forceinline__ float dppz(float v) { return __builtin_bit_cast(float, __builtin_amdgcn_update_dpp(0, __builtin_bit_cast(int, v), CTRL, 0xF, 0xF, true)); }
template <int CTRL> __device__ __forceinline__ float dpps(float v) { return __builtin_bit_cast(float, __builtin_amdgcn_update_dpp(__builtin_bit_cast(int, v), __builtin_bit_cast(int, v), CTRL, 0xF, 0xF, false)); }
__device__ __forceinline__ float rdl(float v, int l) { return __builtin_bit_cast(float, __builtin_amdgcn_readlane(__builtin_bit_cast(int, v), l)); }
__device__ __forceinline__ float wave_max(float v) {
    v = fmaxf(v, dpps<0xB1>(v)); v = fmaxf(v, dpps<0x4E>(v)); v = fmaxf(v, dpps<0x141>(v)); v = fmaxf(v, dpps<0x140>(v));
    return fmaxf(fmaxf(rdl(v, 0), rdl(v, 16)), fmaxf(rdl(v, 32), rdl(v, 48)));
}
__device__ __forceinline__ float scan_add_up(float x, int lane) {
    x += dppz<0x111>(x); x += dppz<0x112>(x); x += dppz<0x114>(x); x += dppz<0x118>(x);
    const float t0 = rdl(x, 15), t1 = rdl(x, 31), t2 = rdl(x, 47); const int row = lane >> 4;
    return x + ((row >= 1 ? t0 : 0.f) + (row >= 2 ? t1 : 0.f) + (row >= 3 ? t2 : 0.f));
}
__device__ __forceinline__ float scan_add_down(float x, int lane) {
    x += dppz<0x101>(x); x += dppz<0x102>(x); x += dppz<0x104>(x); x += dppz<0x108>(x);
    const float t1 = rdl(x, 16), t2 = rdl(x, 32), t3 = rdl(x, 48); const int row = lane >> 4;
    return x + ((row <= 2 ? t3 : 0.f) + (row <= 1 ? t2 : 0.f) + (row <= 0 ? t1 : 0.f));
}
__device__ __forceinline__ float scan_max_up(float x, int lane) {
    x = fmaxf(x, dpps<0x111>(x)); x = fmaxf(x, dpps<0x112>(x)); x = fmaxf(x, dpps<0x114>(x)); x = fmaxf(x, dpps<0x118>(x));
    const float t0 = rdl(x, 15), t1 = rdl(x, 31), t2 = rdl(x, 47); const int row = lane >> 4;
    const float c1 = t0, c2 = fmaxf(t0, t1), c3 = fmaxf(c2, t2);
    return row == 0 ? x : fmaxf(x, row == 1 ? c1 : (row == 2 ? c2 : c3));
}
__device__ __forceinline__ float scan_max_down(float x, int lane) {
    x = fmaxf(x, dpps<0x101>(x)); x = fmaxf(x, dpps<0x102>(x)); x = fmaxf(x, dpps<0x104>(x)); x = fmaxf(x, dpps<0x108>(x));
    const float t1 = rdl(x, 16), t2 = rdl(x, 32), t3 = rdl(x, 48); const int row = lane >> 4;
    const float c2 = t3, c1 = fmaxf(t3, t2), c0 = fmaxf(c1, t1);
    return row == 3 ? x : fmaxf(x, row == 2 ? c2 : (row == 1 ? c1 : c0));
}
__device__ __forceinline__ gm::f32x4 mma_lds(const LAS bf16* A, int lda, int m0, const LAS bf16* Bt, int ldb, int n0, int k0, gm::f32x4 acc, int fr, int fq) {
    const bf16x8t a = *(const LAS bf16x8t*)(A + (m0 + fr) * lda + k0 + 8 * fq), b = *(const LAS bf16x8t*)(Bt + (n0 + fr) * ldb + k0 + 8 * fq);
    return __builtin_amdgcn_mfma_f32_16x16x32_bf16(a, b, acc, 0, 0, 0);
}
template <bool SA, bool SB> __device__ __forceinline__ gm::f32x4 mma_lds_sw(const LAS bf16* A, int lda, int m0, const LAS bf16* Bt, int ldb, int n0, int k0, gm::f32x4 acc, int fr, int fq) {
    const int g = (k0 >> 3) + fq, ga = SA ? (g ^ (((m0 + fr) >> 3) & 7)) : g, gb = SB ? (g ^ (((n0 + fr) >> 3) & 7)) : g;
    const bf16x8t a = *(const LAS bf16x8t*)(A + (m0 + fr) * lda + 8 * ga), b = *(const LAS bf16x8t*)(Bt + (n0 + fr) * ldb + 8 * gb);
    return __builtin_amdgcn_mfma_f32_16x16x32_bf16(a, b, acc, 0, 0, 0);
}
constexpr int LP = 72;
template <int NP, bool SCALED> __device__ __forceinline__ void stage_T(LAS bf16* T, const bf16* g, int ld, int tid, const LAS float* rs0, LAS bf16* T1, const LAS float* rs1) {
    const int s = tid >> 3, part = tid & 7;
#pragma unroll
    for (int it = 0; it < NP / 8; ++it) {
        const u32x4t w = *(const u32x4t*)(g + (size_t)s * ld + (it * 8 + part) * 8); const int c0 = (it * 8 + part) * 8;
        const unsigned ww[4] = {w.x, w.y, w.z, w.w};
#pragma unroll
        for (int q = 0; q < 4; ++q) {
            const float lo = u2f(ww[q] << 16), hi = u2f(ww[q] & 0xFFFF0000u);
            if (SCALED) { const float f0 = rs0[s]; T[(c0 + 2 * q) * LP + s] = f2bf(lo * f0); T[(c0 + 2 * q + 1) * LP + s] = f2bf(hi * f0);
                const float f1 = rs1[s]; T1[(c0 + 2 * q) * LP + s] = f2bf(lo * f1); T1[(c0 + 2 * q + 1) * LP + s] = f2bf(hi * f1); }
            else { T[(c0 + 2 * q) * LP + s] = (bf16)(ww[q] & 0xFFFFu); T[(c0 + 2 * q + 1) * LP + s] = (bf16)(ww[q] >> 16); }
        }
    }
}
template <int R> __device__ __forceinline__ void stage_N(LAS bf16* T, const bf16* g, int ld, int tid) {
#pragma unroll
    for (int it = 0; it < R / 64; ++it) { const int idx = it * 512 + tid, rw = idx >> 3, part = idx & 7;
        *(LAS u32x4t*)(T + rw * LP + part * 8) = *(const u32x4t*)(g + (size_t)rw * ld + part * 8); }
}

__device__ __forceinline__ int swz_tok(int c0, int s) { return (((s >> 3) ^ ((c0 >> 3) & 7)) << 3) + (s & 7); }
__device__ __forceinline__ void putT(LAS bf16* T, const u32x4t w, int c0, int s) {
    const unsigned ww[4] = {w.x, w.y, w.z, w.w}; const int sw = swz_tok(c0, s);
#pragma unroll
    for (int q = 0; q < 4; ++q) { T[(c0 + 2 * q) * LP + sw] = (bf16)(ww[q] & 0xFFFFu); T[(c0 + 2 * q + 1) * LP + sw] = (bf16)(ww[q] >> 16); }
}
__device__ __forceinline__ void putT2(LAS bf16* T0, LAS bf16* T1, const u32x4t w, int c0, int s, float f0, float f1) {
    const unsigned ww[4] = {w.x, w.y, w.z, w.w}; const int sw = swz_tok(c0, s);
#pragma unroll
    for (int q = 0; q < 4; ++q) { const float lo = u2f(ww[q] << 16), hi = u2f(ww[q] & 0xFFFF0000u);
        T0[(c0 + 2 * q) * LP + sw] = f2bf(lo * f0); T0[(c0 + 2 * q + 1) * LP + sw] = f2bf(hi * f0); T1[(c0 + 2 * q) * LP + sw] = f2bf(lo * f1); T1[(c0 + 2 * q + 1) * LP + sw] = f2bf(hi * f1); }
}
__device__ __forceinline__ void o_m1(const Params& p, LAS unsigned char* lds) {
    int tid_ = threadIdx.x; asm volatile("" : "+v"(tid_));
    const int tid = tid_, wid = __builtin_amdgcn_readfirstlane(tid >> 6), lane = tid & 63, fr = lane & 15, fq = lane >> 4;
    constexpr int SETB = (2 * 64 + 128) * LP;
    const bf16* Kb = WSP(bf16, WS_K); const bf16* V = WSP(bf16, WS_V); const float* GT = WSP(float, WS_GT);
    bf16* DC = WSP(bf16, WS_BIG2); float* ND = WSP(float, WS_ND); float* SC = WSP(float, WS_SC);
    const int srow = tid >> 3, part = tid & 7, NU = NB * NH * NCH, G = (int)gridDim.x;
    u32x4t rk, rv0, rv1; float g0, g1, g2, g3;
#define M1_LOAD(u_) do { const int b_ = (u_) / (NH * NCH), h_ = ((u_) / NCH) % NH, c_ = (u_) % NCH; const size_t r_ = (size_t)b_ * S + c_ * 64 + srow; \
        rk = *(const u32x4t*)(Kb + r_ * QKW + h_ * DQK + part * 8); rv0 = *(const u32x4t*)(V + r_ * VW + h_ * DV + part * 8); rv1 = *(const u32x4t*)(V + r_ * VW + h_ * DV + 64 + part * 8); \
        const float* g_ = GT + ((size_t)b_ * S + c_ * 64 + lane) * 32 + h_; g0 = g_[0]; g1 = g_[8]; g2 = g_[16]; g3 = g_[24]; } while (0)
#define M1_STAGE(u_, s_) do { const int b_ = (u_) / (NH * NCH), h_ = ((u_) / NCH) % NH, c_ = (u_) % NCH; \
        LAS bf16* KTf_ = (LAS bf16*)lds + (s_) * SETB; LAS bf16* KTb_ = KTf_ + 64 * LP; LAS bf16* VT_ = KTb_ + 64 * LP; \
        const float bcf = scan_add_up(g1, lane), bcb = scan_add_down(g3, lane); \
        const float BLf = rdl(bcf, 63), BLb = rdl(bcb, 0); \
        const float rawf = BLf - bcf + g0, rawb = BLb - bcb + g2; \
        const float mlf = wave_max(rawf), mlb = wave_max(rawb); \
        const float wf_ = expf(rawf - mlf), wb_ = expf(rawb - mlb);                            \
        const float f0_ = __shfl(wf_, srow), f1_ = __shfl(wb_, srow);                            \
        if (tid == 0) { float* s0 = SC + ((size_t)((0 * NB + b_) * NH + h_) * NCH + c_) * 2; s0[0] = BLf; s0[1] = mlf; \
            float* s1 = SC + ((size_t)((1 * NB + b_) * NH + h_) * NCH + c_) * 2; s1[0] = BLb; s1[1] = mlb; } \
        putT(VT_, rv0, part * 8, srow); putT(VT_, rv1, 64 + part * 8, srow); putT2(KTf_, KTb_, rk, part * 8, srow, f0_, f1_); } while (0)
    int unit = blockIdx.x, set = 0;
    if (unit >= NU) return;
    M1_LOAD(unit); M1_STAGE(unit, 0);
    if (unit + G < NU) M1_LOAD(unit + G);
    __syncthreads();
    for (; unit < NU; unit += G, set ^= 1) {
        const int b = unit / (NH * NCH), h = (unit / NCH) % NH, c = unit % NCH;
        if (unit + G < NU) { M1_STAGE(unit + G, set ^ 1); if (unit + 2 * G < NU) M1_LOAD(unit + 2 * G); }
        const LAS bf16* KTf = (const LAS bf16*)lds + set * SETB; const LAS bf16* KTb = KTf + 64 * LP; const LAS bf16* VT = KTb + 64 * LP;
        {
            const int d = tid >> 8, dk = (tid >> 2) & 63, qt = tid & 3; const LAS bf16* kt = (d ? KTb : KTf) + dk * LP + qt * 16;
            f32x4t a0, a1, a2, a3; unpack8(*(const LAS u32x4t*)kt, a0, a1); unpack8(*(const LAS u32x4t*)(kt + 8), a2, a3);
            const f32x4t t4 = (a0 + a1) + (a2 + a3); float sum = (t4[0] + t4[1]) + (t4[2] + t4[3]);
            sum += dppz<0xB1>(sum); sum += dppz<0x4E>(sum);
            if (qt == 0) ND[((size_t)((d * NB + b) * NH + h) * NCH + c) * DQK + dk] = sum; }
        {
            const int d = wid >> 2, mt = wid & 3; const LAS bf16* A = d ? KTb : KTf;
            bf16* dst = DC + ((size_t)((d * NB + b) * NH + h) * NCH + c) * (DV * DQK);
#pragma unroll
            for (int nt = 0; nt < 8; ++nt) {
                gm::f32x4 acc = {0.f, 0.f, 0.f, 0.f};
                acc = mma_lds_sw<true, true>(A, LP, 16 * mt, VT, LP, 16 * nt, 0, acc, fr, fq); acc = mma_lds_sw<true, true>(A, LP, 16 * mt, VT, LP, 16 * nt, 32, acc, fr, fq);
                *(u32x2t*)(dst + (16 * nt + fr) * DQK + 16 * mt + 4 * fq) = pack4(acc);
            }
        }
        __syncthreads();
    }
#undef M1_LOAD
#undef M1_STAGE
}
__device__ __forceinline__ int chunk_of_order(int d, int o) { return d == 0 ? o : (o < CTX / 64 ? CTX / 64 - 1 - o : NCH - 1 - (o - CTX / 64)); }
__device__ __forceinline__ void o_m2(const Params& p) {
    int tid_ = threadIdx.x; asm volatile("" : "+v"(tid_));
    for (int gt = blockIdx.x * 512 + tid_; gt < 2 * NB * NH * 1024; gt += gridDim.x * 512) {
    const int chain = gt >> 10, e8 = gt & 1023, d = chain / (NB * NH);
    bf16* DC = WSP(bf16, WS_BIG2) + (size_t)chain * NCH * (DV * DQK) + e8 * 8; float* ND = WSP(float, WS_ND) + (size_t)chain * NCH * DQK; const float* SC = WSP(float, WS_SC) + (size_t)chain * NCH * 2; float* MS = WSP(float, WS_MS) + (size_t)chain * NCH;
    float m = 0.f, acc[8], nacc[8];
#pragma unroll
    for (int q = 0; q < 8; ++q) { acc[q] = 0.f; nacc[q] = 0.f; }
    constexpr int PD = 4; static_assert(NCH % PD == 0, "");
    u32x4t wq[PD]; f32x4t aq0[PD], aq1[PD]; float blq[PD], mlq[PD];
#define M2_LOAD(k_, o_) do { const int c_ = chunk_of_order(d, (o_)); wq[k_] = *(const u32x4t*)(DC + (size_t)c_ * (DV * DQK)); blq[k_] = SC[c_ * 2]; mlq[k_] = SC[c_ * 2 + 1]; \
        if (e8 < 8) { const float* np_ = ND + c_ * DQK + e8 * 8; aq0[k_] = *(const f32x4t*)np_; aq1[k_] = *(const f32x4t*)(np_ + 4); } } while (0)
#pragma unroll
    for (int k = 0; k < PD; ++k) { aq0[k] = (f32x4t){0.f, 0.f, 0.f, 0.f}; aq1[k] = aq0[k]; M2_LOAD(k, k); }
    for (int o4 = 0; o4 < NCH; o4 += PD) {
#pragma unroll
        for (int k = 0; k < PD; ++k) {
            const int o = o4 + k, c = chunk_of_order(d, o);
            const float BL = blq[k], ml = mlq[k], mn = fmaxf(BL + m, ml), dec = expf(BL + m - mn), sc = expf(ml - mn);
            bf16* ptr = DC + (size_t)c * (DV * DQK);
            const u32x4t w = wq[k]; const unsigned ww[4] = {w.x, w.y, w.z, w.w}; const f32x4t a0 = aq0[k], a1 = aq1[k];
            u32x4t st; st.x = gm::cvt_pk_bf16(acc[0], acc[1]); st.y = gm::cvt_pk_bf16(acc[2], acc[3]); st.z = gm::cvt_pk_bf16(acc[4], acc[5]); st.w = gm::cvt_pk_bf16(acc[6], acc[7]);
            *(u32x4t*)ptr = st;
            if (e8 < 8) { float* np_ = ND + c * DQK + e8 * 8;
                *(f32x4t*)np_ = (f32x4t){nacc[0], nacc[1], nacc[2], nacc[3]}; *(f32x4t*)(np_ + 4) = (f32x4t){nacc[4], nacc[5], nacc[6], nacc[7]};
                if (e8 == 0) MS[c] = m; }
            if (o + PD < NCH) M2_LOAD(k, o + PD);
#pragma unroll
            for (int q = 0; q < 4; ++q) { acc[2 * q] = dec * acc[2 * q] + sc * u2f(ww[q] << 16); acc[2 * q + 1] = dec * acc[2 * q + 1] + sc * u2f(ww[q] & 0xFFFF0000u); }
#pragma unroll
            for (int q = 0; q < 4; ++q) { nacc[q] = dec * nacc[q] + sc * a0[q]; nacc[4 + q] = dec * nacc[4 + q] + sc * a1[q]; }
            m = mn;
        }
    }
#undef M2_LOAD
    }
}
__device__ __forceinline__ void o_m3(const Params& p, const int i, LAS unsigned char* lds) {
    int tid_ = threadIdx.x; asm volatile("" : "+v"(tid_));
    const int tid = tid_, wid = __builtin_amdgcn_readfirstlane(tid >> 6), lane = tid & 63, fr = lane & 15, fq = lane >> 4, j = i >> 1;
    LAS bf16* QS = (LAS bf16*)lds; LAS bf16* KS = QS + 64 * LP; LAS bf16* VT = KS + 64 * LP; LAS bf16* CF = VT + 128 * LP; LAS bf16* CB = CF + 128 * LP; LAS bf16* SWF = CB + 128 * LP; LAS bf16* SWB = SWF + 64 * LP;
    LAS float* HS = (LAS float*)(SWB + 64 * LP); constexpr int HP = 132;
    const LAS float* WF_DUMMY = (const LAS float*)lds;
    LAS float* SM = HS + 64 * HP;
    const bf16* Q = WSP(bf16, WS_Q); const bf16* Kb = WSP(bf16, WS_K); const bf16* V = WSP(bf16, WS_V); const bf16* O = WSP(bf16, WS_O); const float* GT = WSP(float, WS_GT);
    const bf16* DC = WSP(bf16, WS_BIG2); const float* ND = WSP(float, WS_ND); const float* MS = WSP(float, WS_MS); bf16* RB = WSP(bf16, WS_RB);
    const int srow = tid >> 3, part = tid & 7;
    u32x4t rq, rk, rv0, rv1, rcf0, rcf1, rcb0, rcb1; float g0 = 0.f, g1 = 0.f, g2 = 0.f, g3 = 0.f, gms0 = 0.f, gms1 = 0.f, gnd0 = 0.f, gnd1 = 0.f;
#define M3NT(ptr_) __builtin_nontemporal_load((const u32x4t*)(ptr_))
#define M3_LOAD(u_) do { const int b_ = (u_) / (NH * NCH), h_ = ((u_) / NCH) % NH, c_ = (u_) % NCH; const size_t r_ = (size_t)b_ * S + c_ * 64 + srow; \
        const size_t c0_ = (size_t)((0 * NB + b_) * NH + h_) * NCH + c_, c1_ = (size_t)((1 * NB + b_) * NH + h_) * NCH + c_; \
        rq = M3NT(Q + r_ * QKW + h_ * DQK + part * 8); rk = M3NT(Kb + r_ * QKW + h_ * DQK + part * 8); \
        rv0 = M3NT(V + r_ * VW + h_ * DV + part * 8); rv1 = M3NT(V + r_ * VW + h_ * DV + 64 + part * 8); \
        rcf0 = *(const u32x4t*)(DC + c0_ * (DV * DQK) + (size_t)srow * DQK + part * 8); rcf1 = *(const u32x4t*)(DC + c0_ * (DV * DQK) + (size_t)(64 + srow) * DQK + part * 8); \
        rcb0 = *(const u32x4t*)(DC + c1_ * (DV * DQK) + (size_t)srow * DQK + part * 8); rcb1 = *(const u32x4t*)(DC + c1_ * (DV * DQK) + (size_t)(64 + srow) * DQK + part * 8); \
        if (wid == 0) { const float* g_ = GT + ((size_t)b_ * S + c_ * 64 + lane) * 32 + h_; g0 = g_[0]; g1 = g_[8]; g2 = g_[16]; g3 = g_[24]; gms0 = MS[c0_]; gms1 = MS[c1_]; gnd0 = ND[c0_ * DQK + lane]; gnd1 = ND[c1_ * DQK + lane]; } } while (0)
    int unit = blockIdx.x;
    if (unit < NB * NH * NCH) M3_LOAD(unit);
    for (; unit < NB * NH * NCH; unit += gridDim.x) {
        const int b = unit / (NH * NCH), h = (unit / NCH) % NH, c = unit % NCH; const size_t r0 = (size_t)b * S + c * 64;
        if (wid == 0) {
            const float gif = g0, lff = g1, gib = g2, lfb = g3;
            const float bcf = scan_add_up(lff, lane), bcb = scan_add_down(lfb, lane);
            const float af = gif - bcf, ab = gib - bcb;
            const float mpf = gms0, mpb = gms1;
            const float mxf = fmaxf(mpf, scan_max_up(af, lane)), mxb = fmaxf(mpb, scan_max_down(ab, lane));
            SM[lane] = af; SM[64 + lane] = -mxf; SM[128 + lane] = expf(mpf - mxf); SM[192 + lane] = expf(-(bcf + mxf)); SM[320 + lane] = gnd0;
            SM[384 + lane] = ab; SM[384 + 64 + lane] = -mxb; SM[384 + 128 + lane] = expf(mpb - mxb); SM[384 + 192 + lane] = expf(-(bcb + mxb)); SM[384 + 320 + lane] = gnd1;
        }
        *(LAS u32x4t*)(QS + srow * LP + part * 8) = rq; *(LAS u32x4t*)(KS + srow * LP + part * 8) = rk;
        putT(VT, rv0, part * 8, srow); putT(VT, rv1, 64 + part * 8, srow);
        *(LAS u32x4t*)(CF + srow * LP + part * 8) = rcf0; *(LAS u32x4t*)(CF + (64 + srow) * LP + part * 8) = rcf1;
        *(LAS u32x4t*)(CB + srow * LP + part * 8) = rcb0; *(LAS u32x4t*)(CB + (64 + srow) * LP + part * 8) = rcb1;
        __syncthreads();
        if (unit + (int)gridDim.x < NB * NH * NCH) M3_LOAD(unit + (int)gridDim.x);
        {
            const int mt = wid & 3;
#pragma unroll
            for (int q = 0; q < 2; ++q) { const int nt = (wid >> 2) * 2 + q;
                gm::f32x4 acc = {0.f, 0.f, 0.f, 0.f};
                acc = mma_lds(QS, LP, 16 * mt, KS, LP, 16 * nt, 0, acc, fr, fq); acc = mma_lds(QS, LP, 16 * mt, KS, LP, 16 * nt, 32, acc, fr, fq);
                const int s = 16 * nt + fr; const float afs = SM[s], abs_ = SM[384 + s];
#pragma unroll
                for (int jj = 0; jj < 4; ++jj) { const int jr = 16 * mt + 4 * fq + jj;
                    const float wf = (s <= jr) ? __expf(SM[64 + jr] + afs) : 0.f, wb = (s >= jr) ? __expf(SM[384 + 64 + jr] + abs_) : 0.f;
                    SWF[jr * LP + s] = f2bf(acc[jj] * wf); SWB[jr * LP + s] = f2bf(acc[jj] * wb); }
            }
        }
        __syncthreads();
        {
            const int d = tid >> 8, jr = (tid >> 2) & 63, sg = (tid & 3) * 16; const LAS bf16* sw = (d ? SWB : SWF) + jr * LP + sg; const LAS float* sm = SM + d * 384; float rs = 0.f, qn = 0.f;
#pragma unroll
            for (int s = 0; s < 16; ++s) { rs += bf2f(sw[s]); qn += bf2f(QS[jr * LP + sg + s]) * sm[320 + sg + s]; }
            rs += __shfl_xor(rs, 1); qn += __shfl_xor(qn, 1); rs += __shfl_xor(rs, 2); qn += __shfl_xor(qn, 2);
            const float den = rs + sm[128 + jr] * qn;
            if ((tid & 3) == 0) SM[d * 384 + 256 + jr] = 1.0f / fmaxf(fabsf(den), sm[192 + jr]); }
        gm::f32x4 a1f[4], a2f[4], a1b[4], a2b[4];
        {
            const int mt = wid & 3, ntb = (wid >> 2) * 4;
#pragma unroll
            for (int q = 0; q < 4; ++q) { const int n0 = 16 * (ntb + q);
                gm::f32x4 z = {0.f, 0.f, 0.f, 0.f};
                a1f[q] = mma_lds_sw<false, true>(SWF, LP, 16 * mt, VT, LP, n0, 32, mma_lds_sw<false, true>(SWF, LP, 16 * mt, VT, LP, n0, 0, z, fr, fq), fr, fq);
                a2f[q] = mma_lds(QS, LP, 16 * mt, CF, LP, n0, 32, mma_lds(QS, LP, 16 * mt, CF, LP, n0, 0, z, fr, fq), fr, fq);
                a1b[q] = mma_lds_sw<false, true>(SWB, LP, 16 * mt, VT, LP, n0, 32, mma_lds_sw<false, true>(SWB, LP, 16 * mt, VT, LP, n0, 0, z, fr, fq), fr, fq);
                a2b[q] = mma_lds(QS, LP, 16 * mt, CB, LP, n0, 32, mma_lds(QS, LP, 16 * mt, CB, LP, n0, 0, z, fr, fq), fr, fq);
            }
        }
        __syncthreads();
        {
            const int mt = wid & 3, ntb = (wid >> 2) * 4;
#pragma unroll
            for (int jj = 0; jj < 4; ++jj) { const int jr = 16 * mt + 4 * fq + jj;
                const float wif = SM[128 + jr], ivf = SM[256 + jr], wib = SM[384 + 128 + jr], ivb = SM[384 + 256 + jr];
#pragma unroll
                for (int q = 0; q < 4; ++q) HS[jr * HP + 16 * (ntb + q) + fr] = (a1f[q][jj] + wif * a2f[q][jj]) * ivf + (a1b[q][jj] + wib * a2b[q][jj]) * ivb;
            }
        }
        __syncthreads();
        {
            const int row = tid >> 3, seg = tid & 7; const LAS float* hp = HS + row * HP + seg * 8;
            f32x4t hv[4]; float ss = 0.f;
#pragma unroll
            for (int q = 0; q < 4; ++q) { hv[q] = *(const LAS f32x4t*)(hp + (q >> 1) * 64 + (q & 1) * 4); ss += hv[q][0] * hv[q][0] + hv[q][1] * hv[q][1] + hv[q][2] * hv[q][2] + hv[q][3] * hv[q][3]; }
            ss += __shfl_xor(ss, 1); ss += __shfl_xor(ss, 2); ss += __shfl_xor(ss, 4);
            const float rs = 1.0f / sqrtf(ss * (1.0f / (float)DV) + EPS);
            const int col = h * DV + seg * 8; const size_t r = r0 + row;
#pragma unroll
            for (int q = 0; q < 2; ++q) {
                const u32x4t ow = M3NT(O + r * VW + col + 64 * q);
                const f32x4t g0 = *(const f32x4t*)(p.m_g_head + j * VW + col + 64 * q), g1 = *(const f32x4t*)(p.m_g_head + j * VW + col + 64 * q + 4);
                const f32x4t o0 = unpack4((u32x2t){ow.x, ow.y}), o1 = unpack4((u32x2t){ow.z, ow.w});
                const u32x2t w0 = pack4(hv[2 * q] * rs * g0 * o0), w1 = pack4(hv[2 * q + 1] * rs * g1 * o1);
                *(u32x4t*)(RB + r * RBK + col + 64 * q) = (u32x4t){w0.x, w0.y, w1.x, w1.y};
            }
        }
        __syncthreads();
    }
}

constexpr int XP = 136;
__device__ __forceinline__ float neg_expm1(float x) {
    return x > -0.125f ? -x * (1.0f + x * (0.5f + x * (0.16666667f + x * (0.041666668f + x * 0.0083333338f)))) : 1.0f - __expf(x);
}
__device__ __forceinline__ bf16* rg_arr(const Params& p, int which) { return which < 2 ? WSP(bf16, WS_BIG2) + (size_t)which * (MROWS * D + SKEW / 2) : WSP(bf16, WS_XC); }
__device__ __forceinline__ void o_rg1(const Params& p, const int i, LAS unsigned char* lds) {
    int tid_ = threadIdx.x; asm volatile("" : "+v"(tid_));
    const int tid = tid_, wid = __builtin_amdgcn_readfirstlane(tid >> 6), lane = tid & 63, fr = lane & 15, fq = lane >> 4, j = i >> 1;
    const int nblk = blockIdx.x & 7, jc = wid * 16 + fr, ch = nblk * RBW + jc;
    LAS bf16* XC = (LAS bf16*)lds; LAS float* CW = (LAS float*)(lds + 17408);
    const bf16* XR = WSP(bf16, WS_XR); float* RSUM = WSP(float, WS_RSUM);
    for (int it = tid; it < 5 * RBW; it += 512) { const int t = it / RBW, c2 = it % RBW; CW[it] = t < 4 ? p.r_conv_w[(j * 4 + t) * D + nblk * RBW + c2] : p.r_conv_b[j * D + nblk * RBW + c2]; }
    bf16x8t Br[2][4], Bi[2][4]; float sp8[2], sp8l[2], nbr[2], nbi[2];
#pragma unroll
    for (int d = 0; d < 2; ++d) {
        const bf16* wg = WSP(bf16, WS_WG) + ((size_t)(j * 2 + d) * 8 + nblk) * 2 * RBW * RBW;
#pragma unroll
        for (int ks = 0; ks < 4; ++ks) { Br[d][ks] = *(const bf16x8t*)(wg + (size_t)jc * RBW + ks * 32 + 8 * fq); Bi[d][ks] = *(const bf16x8t*)(wg + (size_t)(RBW + jc) * RBW + ks * 32 + 8 * fq); }
        sp8[d] = 8.0f * softplusf_(-p.r_lam[(j * 2 + d) * D + ch]);
        const float* bg = p.r_b_gate + ((size_t)(j * 2 + d) * 8 + nblk) * 2 * RBW; nbr[d] = -1.4426950408889634f * bg[jc]; nbi[d] = -1.4426950408889634f * bg[RBW + jc]; sp8l[d] = 1.4426950408889634f * sp8[d];
    }
    __syncthreads();
    for (int k = 0; k < (NB * NCH + 31) / 32; ++k) {
        const int bc = k * 32 + (blockIdx.x >> 3); if (bc >= NB * NCH) break;
        const int b = bc / NCH, c = bc % NCH;
        const int seg_lo = c < CTX / 64 ? 0 : CTX, seg_hi = c < CTX / 64 ? CTX : S;
        {
            const int token = tid >> 3, cg = tid & 7, s = c * 64 + token;
            f32x4t y[4];
#pragma unroll
            for (int q = 0; q < 4; ++q) y[q] = *(const LAS f32x4t*)(CW + 4 * RBW + cg * 16 + 4 * q);
#pragma unroll
            for (int t = 0; t < 4; ++t) { const int ss = s + t - 2;
                if (ss >= seg_lo && ss < seg_hi) { const bf16* src = XR + ((size_t)b * S + ss) * D + nblk * RBW + cg * 16;
                    const u32x4t w0 = *(const u32x4t*)src, w1 = *(const u32x4t*)(src + 8);
                    const f32x4t x0 = unpack4((u32x2t){w0.x, w0.y}), x1 = unpack4((u32x2t){w0.z, w0.w}), x2 = unpack4((u32x2t){w1.x, w1.y}), x3 = unpack4((u32x2t){w1.z, w1.w});
                    const LAS float* cw = CW + t * RBW + cg * 16;
                    y[0] += *(const LAS f32x4t*)(cw) * x0; y[1] += *(const LAS f32x4t*)(cw + 4) * x1; y[2] += *(const LAS f32x4t*)(cw + 8) * x2; y[3] += *(const LAS f32x4t*)(cw + 12) * x3; } }
            const u32x2t p0 = pack4(y[0]), p1 = pack4(y[1]), p2 = pack4(y[2]), p3 = pack4(y[3]);
            *(LAS u32x4t*)(XC + token * XP + cg * 16) = (u32x4t){p0.x, p0.y, p1.x, p1.y}; *(LAS u32x4t*)(XC + token * XP + cg * 16 + 8) = (u32x4t){p2.x, p2.y, p3.x, p3.y};
        }
        __syncthreads();
        const size_t aoff = ((((size_t)bc * 8 + nblk) * 8 + wid) * 64 + lane) * 16;
        float hl[16];
#pragma unroll
        for (int d = 0; d < 2; ++d) {
            gm::f32x4 ar[4], ai[4];
#pragma unroll
            for (int mt = 0; mt < 4; ++mt) { ar[mt] = (gm::f32x4){0.f, 0.f, 0.f, 0.f}; ai[mt] = (gm::f32x4){0.f, 0.f, 0.f, 0.f}; }
#pragma unroll
            for (int ks = 0; ks < 4; ++ks)
#pragma unroll
                for (int mt = 0; mt < 4; ++mt) {
                    const bf16x8t a = *(const LAS bf16x8t*)(XC + ((fr >> 2) * 16 + mt * 4 + (fr & 3)) * XP + ks * 32 + 8 * fq);
                    ar[mt] = __builtin_amdgcn_mfma_f32_16x16x32_bf16(a, Br[d][ks], ar[mt], 0, 0, 0); ai[mt] = __builtin_amdgcn_mfma_f32_16x16x32_bf16(a, Bi[d][ks], ai[mt], 0, 0, 0);
                }
            float av[16], bx[16];
#pragma unroll
            for (int q = 0; q < 16; ++q) {
                const float sr = __builtin_amdgcn_rcpf(1.0f + __builtin_amdgcn_exp2f(fmaf(ar[q >> 2][q & 3], -1.4426950408889634f, nbr[d]))), si = __builtin_amdgcn_rcpf(1.0f + __builtin_amdgcn_exp2f(fmaf(ai[q >> 2][q & 3], -1.4426950408889634f, nbi[d])));
                const float a_ = __builtin_amdgcn_exp2f(-sp8l[d] * sr), x2 = -2.0f * sp8[d] * sr;
                const float om = x2 > -0.0625f ? -x2 * (1.0f + x2 * (0.5f + x2 * (0.16666667f + x2 * 0.041666668f))) : fmaf(-a_, a_, 1.0f);
                av[q] = a_; bx[q] = __builtin_amdgcn_sqrtf(om) * si * bf2f(XC[(16 * fq + q) * XP + jc]);
            }
            float P = 1.0f, H = 0.f;
#pragma unroll
            for (int o = 0; o < 16; ++o) { const int q = d ? 15 - o : o; H = av[q] * H + bx[q]; P *= av[q]; }
            float Pg[4], Hg[4];
#pragma unroll
            for (int g = 0; g < 4; ++g) { Pg[g] = __shfl(P, fr + 16 * g); Hg[g] = __shfl(H, fr + 16 * g); }
            float st = 0.f, pt = 1.0f, myc = 0.f, myp = 1.0f;
#pragma unroll
            for (int pg = 0; pg < 4; ++pg) { const int g = d ? 3 - pg : pg; if (g == fq) { myc = st; myp = pt; } st = Pg[g] * st + Hg[g]; pt *= Pg[g]; }
            const size_t sidx = ((size_t)(d * NB + b) * NCH + c) * D + ch;
            if (fq == 0) { RSUM[sidx * 2] = pt; RSUM[sidx * 2 + 1] = st; }
            float pc[16]; float hh = myc, pp = myp;
#pragma unroll
            for (int o = 0; o < 16; ++o) { const int q = d ? 15 - o : o; hh = av[q] * hh + bx[q]; pp *= av[q]; pc[q] = pp; if (d == 0) hl[q] = hh; else hl[q] += hh; }
            {
                u32x4t w0, w1; bf16* pp_ = rg_arr(p, 1 + d) + aoff;
                w0.x = gm::cvt_pk_bf16(pc[0], pc[1]); w0.y = gm::cvt_pk_bf16(pc[2], pc[3]); w0.z = gm::cvt_pk_bf16(pc[4], pc[5]); w0.w = gm::cvt_pk_bf16(pc[6], pc[7]);
                w1.x = gm::cvt_pk_bf16(pc[8], pc[9]); w1.y = gm::cvt_pk_bf16(pc[10], pc[11]); w1.z = gm::cvt_pk_bf16(pc[12], pc[13]); w1.w = gm::cvt_pk_bf16(pc[14], pc[15]);
                *(u32x4t*)pp_ = w0; *(u32x4t*)(pp_ + 8) = w1;
            }
        }
        {
            u32x4t w0, w1; bf16* hp_ = rg_arr(p, 0) + aoff;
            w0.x = gm::cvt_pk_bf16(hl[0], hl[1]); w0.y = gm::cvt_pk_bf16(hl[2], hl[3]); w0.z = gm::cvt_pk_bf16(hl[4], hl[5]); w0.w = gm::cvt_pk_bf16(hl[6], hl[7]);
            w1.x = gm::cvt_pk_bf16(hl[8], hl[9]); w1.y = gm::cvt_pk_bf16(hl[10], hl[11]); w1.z = gm::cvt_pk_bf16(hl[12], hl[13]); w1.w = gm::cvt_pk_bf16(hl[14], hl[15]);
            *(u32x4t*)hp_ = w0; *(u32x4t*)(hp_ + 8) = w1;
        }
        __syncthreads();
    }
}
__device__ __forceinline__ void o_rg3(const Params& p, const int i, LAS unsigned char* lds) {
    int tid_ = threadIdx.x; asm volatile("" : "+v"(tid_));
    const int tid = tid_, wid = __builtin_amdgcn_readfirstlane(tid >> 6), lane = tid & 63, fr = lane & 15, fq = lane >> 4;
    const int nblk = blockIdx.x & 7, jc = wid * 16 + fr, ch = nblk * RBW + jc;
    LAS float* HS = (LAS float*)lds; constexpr int HP = 132;
    const bf16* GY = WSP(bf16, WS_GY); bf16* RB = WSP(bf16, WS_RB); const float* CIN = WSP(float, WS_RCIN);
    for (int k = 0; k < (NB * NCH + 31) / 32; ++k) {
        const int bc = k * 32 + (blockIdx.x >> 3); if (bc >= NB * NCH) break;
        const int b = bc / NCH, c = bc % NCH;
        if (i == DEPTH - 1 && c < CTX / 64) continue;
        const size_t r0 = (size_t)b * S + c * 64;
        const size_t aoff = ((((size_t)bc * 8 + nblk) * 8 + wid) * 64 + lane) * 16;
        u32x4t w[3][2];
#pragma unroll
        for (int a3 = 0; a3 < 3; ++a3) { const bf16* ap = rg_arr(p, a3) + aoff; w[a3][0] = *(const u32x4t*)ap; w[a3][1] = *(const u32x4t*)(ap + 8); }
        const float cf = CIN[((size_t)(0 * NB + b) * NCH + c) * D + ch], cb = CIN[((size_t)(1 * NB + b) * NCH + c) * D + ch];
#pragma unroll
        for (int hlf = 0; hlf < 2; ++hlf) {
            const unsigned uh[4] = {w[0][hlf].x, w[0][hlf].y, w[0][hlf].z, w[0][hlf].w}, uf[4] = {w[1][hlf].x, w[1][hlf].y, w[1][hlf].z, w[1][hlf].w}, ub[4] = {w[2][hlf].x, w[2][hlf].y, w[2][hlf].z, w[2][hlf].w};
#pragma unroll
            for (int q2 = 0; q2 < 4; ++q2) { const int q = 8 * hlf + 2 * q2;
                HS[(16 * fq + q) * HP + jc] = u2f(uh[q2] << 16) + u2f(uf[q2] << 16) * cf + u2f(ub[q2] << 16) * cb;
                HS[(16 * fq + q + 1) * HP + jc] = u2f(uh[q2] & 0xFFFF0000u) + u2f(uf[q2] & 0xFFFF0000u) * cf + u2f(ub[q2] & 0xFFFF0000u) * cb; }
        }
        __syncthreads();
        {
            const int token = tid >> 3, cg = tid & 7; const size_t r = r0 + token;
            const bf16* gy = GY + r * D + nblk * RBW + cg * 8; const u32x4t g0 = *(const u32x4t*)gy, g1 = *(const u32x4t*)(gy + 64);
            const LAS float* hp = HS + token * HP + cg * 8;
            const u32x2t o0 = pack4(unpack4((u32x2t){g0.x, g0.y}) * *(const LAS f32x4t*)(hp)), o1 = pack4(unpack4((u32x2t){g0.z, g0.w}) * *(const LAS f32x4t*)(hp + 4)),
                         o2 = pack4(unpack4((u32x2t){g1.x, g1.y}) * *(const LAS f32x4t*)(hp + 64)), o3 = pack4(unpack4((u32x2t){g1.z, g1.w}) * *(const LAS f32x4t*)(hp + 68));
            bf16* dst = RB + r * RBK + nblk * RBW + cg * 8;
            *(u32x4t*)dst = (u32x4t){o0.x, o0.y, o1.x, o1.y}; *(u32x4t*)(dst + 64) = (u32x4t){o2.x, o2.y, o3.x, o3.y};
        }
        __syncthreads();
    }
}
__device__ __forceinline__ void o_rg2(const Params& p) {
    int tid_ = threadIdx.x; asm volatile("" : "+v"(tid_));
    const float* RSUM = WSP(float, WS_RSUM); float* CIN = WSP(float, WS_RCIN);
    if (tid_ >= 64) return;
    for (int gt = blockIdx.x * 64 + tid_; gt < 2 * NB * D; gt += gridDim.x * 64) {
        const int chn = gt % D, db = gt / D, d = db / NB; float carry = 0.f;
        f32x2 ph[NCH];
#pragma unroll
        for (int o = 0; o < NCH; ++o) { const int c = chunk_of_order(d, o); ph[o] = *(const f32x2*)(RSUM + (((size_t)db * NCH + c) * D + chn) * 2); }
#pragma unroll
        for (int o = 0; o < NCH; ++o) { const int c = chunk_of_order(d, o); CIN[((size_t)db * NCH + c) * D + chn] = carry; carry = ph[o][0] * carry + ph[o][1]; }
    }
}

__device__ __forceinline__ void n_m1x(const Params& p, size_t gtid, size_t nthr) {
    const bf16* Kb = WSP(bf16, WS_K); const bf16* V = WSP(bf16, WS_V); const float* GT = WSP(float, WS_GT);
    bf16* DC = WSP(bf16, WS_BIG2); float* ND = WSP(float, WS_ND); float* SC = WSP(float, WS_SC);
    for (size_t it = gtid; it < (size_t)2 * NB * NH * NCH * DV; it += nthr) {
        const int v = (int)(it % DV); const size_t ch = it / DV; const int c = (int)(ch % NCH), h = (int)((ch / NCH) % NH), b = (int)((ch / (NCH * NH)) % NB), d = (int)(ch / ((size_t)NCH * NH * NB));
        const size_t r0 = (size_t)b * S + c * 64;
        float BL = 0.f; for (int s = 0; s < 64; ++s) BL += GT[(r0 + s) * 32 + (2 * d + 1) * 8 + h];
        float bc = 0.f, ml = -3.0e38f;
        for (int o = 0; o < 64; ++o) { const int s = d == 0 ? o : 63 - o; bc += GT[(r0 + s) * 32 + (2 * d + 1) * 8 + h]; ml = fmaxf(ml, BL - bc + GT[(r0 + s) * 32 + (2 * d) * 8 + h]); }
        float acc[DQK], nn[DQK];
#pragma unroll
        for (int k = 0; k < DQK; ++k) { acc[k] = 0.f; nn[k] = 0.f; }
        bc = 0.f;
        for (int o = 0; o < 64; ++o) { const int s = d == 0 ? o : 63 - o; bc += GT[(r0 + s) * 32 + (2 * d + 1) * 8 + h];
            const float w = expf(BL - bc + GT[(r0 + s) * 32 + (2 * d) * 8 + h] - ml), vv = bf2f(V[(r0 + s) * VW + h * DV + v]);
#pragma unroll
            for (int k = 0; k < DQK; ++k) { const float kw = bf2f(f2bf(bf2f(Kb[(r0 + s) * QKW + h * DQK + k]) * w)); acc[k] += vv * kw; nn[k] += kw; } }
#pragma unroll
        for (int k = 0; k < DQK; ++k) DC[ch * (DV * DQK) + (size_t)v * DQK + k] = f2bf(acc[k]);
        if (v == 0) {
#pragma unroll
            for (int k = 0; k < DQK; ++k) ND[ch * DQK + k] = nn[k];
            SC[ch * 2] = BL; SC[ch * 2 + 1] = ml; }
    }
}
__device__ __forceinline__ void n_m3x(const Params& p, size_t gtid, size_t nthr) {
    const bf16* Q = WSP(bf16, WS_Q); const bf16* Kb = WSP(bf16, WS_K); const bf16* V = WSP(bf16, WS_V); const float* GT = WSP(float, WS_GT);
    const bf16* DC = WSP(bf16, WS_BIG2); const float* ND = WSP(float, WS_ND); const float* MS = WSP(float, WS_MS); bf16* HB = WSP(bf16, WS_HB);
    for (size_t it = gtid; it < (size_t)NB * NH * NCH * 64 * 8; it += nthr) {
        const int vg = (int)(it & 7), jr = (int)((it >> 3) & 63); const int unit = (int)(it >> 9); const int b = unit / (NH * NCH), h = (unit / NCH) % NH, c = unit % NCH; const size_t r0 = (size_t)b * S + c * 64;
        float out[16];
#pragma unroll
        for (int q = 0; q < 16; ++q) out[q] = 0.f;
        for (int d = 0; d < 2; ++d) {
            const size_t ch = (size_t)((d * NB + b) * NH + h) * NCH + c; const float mprev = MS[ch];
            float bc = 0.f, pm = -3.0e38f;
            for (int o = 0; o < 64; ++o) { const int s = d == 0 ? o : 63 - o; bc += GT[(r0 + s) * 32 + (2 * d + 1) * 8 + h]; pm = fmaxf(pm, GT[(r0 + s) * 32 + (2 * d) * 8 + h] - bc); if (s == jr) break; }
            const float bcj = bc, mx = fmaxf(mprev, pm), mpos = bcj + mx, wint = expf(mprev - mx);
            float num[16]; float den = 0.f;
#pragma unroll
            for (int q = 0; q < 16; ++q) num[q] = 0.f;
            bc = 0.f;
            for (int o = 0; o < 64; ++o) { const int s = d == 0 ? o : 63 - o; bc += GT[(r0 + s) * 32 + (2 * d + 1) * 8 + h];
                const float w = expf(GT[(r0 + s) * 32 + (2 * d) * 8 + h] - bc - mx);
                float sj = 0.f; for (int k = 0; k < DQK; ++k) sj += bf2f(Q[(r0 + jr) * QKW + h * DQK + k]) * bf2f(Kb[(r0 + s) * QKW + h * DQK + k]);
                const float sw = bf2f(f2bf(sj * w)); den += sw;
#pragma unroll
                for (int q = 0; q < 16; ++q) num[q] += sw * bf2f(V[(r0 + s) * VW + h * DV + vg * 16 + q]);
                if (s == jr) break; }
            float qn = 0.f; float qc[16];
#pragma unroll
            for (int q = 0; q < 16; ++q) qc[q] = 0.f;
            for (int k = 0; k < DQK; ++k) { const float qq = bf2f(Q[(r0 + jr) * QKW + h * DQK + k]); qn += qq * ND[ch * DQK + k];
#pragma unroll
                for (int q = 0; q < 16; ++q) qc[q] += qq * bf2f(DC[ch * (DV * DQK) + (size_t)(vg * 16 + q) * DQK + k]); }
            const float dn = den + wint * qn, inv = 1.0f / fmaxf(fabsf(dn), expf(-mpos));
#pragma unroll
            for (int q = 0; q < 16; ++q) out[q] += (num[q] + wint * qc[q]) * inv;
        }
#pragma unroll
        for (int q = 0; q < 16; ++q) HB[(r0 + jr) * D + h * DV + vg * 16 + q] = f2bf(out[q]);
    }
}
__device__ __forceinline__ void n_m3y(const Params& p, int i, size_t gtid, size_t nthr) {
    const bf16* HB = WSP(bf16, WS_HB); const bf16* O = WSP(bf16, WS_O); bf16* RB = WSP(bf16, WS_RB); const int j = i >> 1;
    for (size_t it = gtid; it < (size_t)MROWS * NH; it += nthr) {
        const size_t r = it / NH; const int h = (int)(it % NH);
        float ss = 0.f; for (int v = 0; v < DV; ++v) { const float x = bf2f(HB[r * D + h * DV + v]); ss += x * x; }
        const float rs = 1.0f / sqrtf(ss / (float)DV + EPS);
        for (int v = 0; v < DV; ++v) { const int c = h * DV + v; RB[r * RBK + c] = f2bf(bf2f(HB[r * D + c]) * rs * p.m_g_head[j * VW + c] * bf2f(O[r * VW + c])); }
    }
}

typedef const __attribute__((address_space(4))) Params* KParams;
__device__ __forceinline__ Params load_params() {
    KParams pp = (KParams)__builtin_amdgcn_kernarg_segment_ptr();
    asm volatile("" : "+s"(pp) :: "memory");
#if defined(__HIP_DEVICE_COMPILE__)
    return *pp;
#else
    return Params{};
#endif
}
#define GT_NT unsigned t_ = threadIdx.x; asm volatile("" : "+v"(t_)); const size_t gtid = (size_t)blockIdx.x * 512 + t_, nthr = (size_t)gridDim.x * 512
__global__ void __launch_bounds__(512, 2) mega(Params p_) {
    extern __shared__ __attribute__((aligned(16))) unsigned char lds[];
    const int tid = threadIdx.x;
    volatile LAS unsigned* misc = (volatile LAS unsigned*)((LAS unsigned char*)lds + LDS_MISC);
    if (tid < 64) misc[tid] = 0u;
    __syncthreads();
    XcdBarrier bar = xcd_barrier_post((unsigned*)(p_.ws + WS_CTL) + CW_BAR, misc + 8);
    const int lo = p_.ph_lo, hi = p_.ph_hi;
#define IN(k) (lo <= (k) && (k) < hi)
#define SEAM(k) do { if (IN((k) + 1)) xcd_barrier(bar); } while (0)
#ifndef PROBE_DOUBLE
#define PROBE_DOUBLE 0
#endif
#define REPP(bit, call) if (PROBE_DOUBLE & (bit)) { __syncthreads(); const Params p = load_params(); call; }
#define NPH(k, call) if (IN(k)) { { const Params p = load_params(); GT_NT; call; } SEAM(k); }
#define OPH(k, call) if (IN(k)) { { const Params p = load_params(); call; } SEAM(k); }
    OPH(0, o_p0(p, (LAS unsigned char*)lds))
    for (int i = 0; i < DEPTH; ++i) {
        const int b = 2 + i * PH_PER_LAYER; const bool ml = (i & 1) == 0;
        OPH(b + 0, o_t1(p, i))
        if (IN(b + 1)) { { const Params p = load_params(); if (o_g1(p, i, (LAS unsigned char*)lds)) fill_tiles(p, (LAS unsigned char*)lds, 4, P0_DEFER, false); } SEAM(b + 1); }
        if (ml) {
            if (IN(b + 2)) { { const Params p = load_params(); o_m1(p, (LAS unsigned char*)lds); } REPP(8, o_m1(p, (LAS unsigned char*)lds)) SEAM(b + 2); }
            OPH(b + 3, o_m2(p))
            if (IN(b + 4)) { { const Params p = load_params(); o_m3(p, i, (LAS unsigned char*)lds); } REPP(16, o_m3(p, i, (LAS unsigned char*)lds)) SEAM(b + 5); }
        } else {
            if (IN(b + 2)) { { const Params p = load_params(); o_rg1(p, i, (LAS unsigned char*)lds); } REPP(32, o_rg1(p, i, (LAS unsigned char*)lds)) SEAM(b + 2); }
            OPH(b + 3, o_rg2(p))
            if (IN(b + 4)) { { const Params p = load_params(); o_rg3(p, i, (LAS unsigned char*)lds); } REPP(64, o_rg3(p, i, (LAS unsigned char*)lds)) SEAM(b + 5); }
        }
        if (IN(b + 6)) { { const Params p = load_params(); if (o_g2(p, i, (LAS unsigned char*)lds)) fill_tiles(p, (LAS unsigned char*)lds, 4, P0_DEFER, false); } SEAM(b + 6); }
        if (IN(b + 7)) { { const Params p = load_params();
            int qv = 0x7fffffff; if (i > 0 && tid == 0) qv = __hip_atomic_load((int*)(p.ws + WS_CTL) + CW_FILLQ, __ATOMIC_RELAXED, __HIP_MEMORY_SCOPE_AGENT);
            o_t2(p, i, (LAS unsigned char*)lds);
            if (i > 0) { if (tid == 0) misc[17] = qv < i * P0_LAYER_E ? 1u : 0u; __syncthreads(); if (misc[17]) fill_tiles(p, (LAS unsigned char*)lds, 2, i * P0_LAYER_E, true); } }
            SEAM(b + 7); }
        if (IN(b + 8)) { { const Params p = load_params(); if (o_g3(p, i, (LAS unsigned char*)lds)) fill_tiles(p, (LAS unsigned char*)lds, 4, P0_DEFER, false); } SEAM(b + 8); }
        if (IN(b + 9)) { { const Params p = load_params(); if (o_g4(p, i, (LAS unsigned char*)lds, IN(b + 8))) fill_tiles(p, (LAS unsigned char*)lds, 2, P0_DEFER, false); } SEAM(b + 9); }
    }
    if (IN(2 + DEPTH * PH_PER_LAYER)) { const Params p = load_params(); o_t1(p, DEPTH); }
#undef IN
#undef SEAM
}

extern "C" void kernel_launch(void* const* d_in, const int* in_sizes, int n_in, void* d_out, int out_size, void* d_ws, size_t ws_size, hipStream_t stream) {
    static int grid = 0;
    if (grid == 0) {
        if (n_in != 25 || in_sizes[0] != NB * SEQ * D || out_size != NB * SEQ * D || ws_size < WS_END) {
            fprintf(stderr, "kernel_launch: unexpected shapes / workspace (n_in %d, in0 %d, out %d, ws %zu < %zu): nothing launched\n", n_in, n_in > 0 ? in_sizes[0] : -1, out_size, ws_size, (size_t)WS_END);
            grid = -1; return;
        }
        int dev = 0, cus = 0, per_cu = 0;
        if (hipGetDevice(&dev) != hipSuccess || hipDeviceGetAttribute(&cus, hipDeviceAttributeMultiprocessorCount, dev) != hipSuccess) { grid = -1; return; }
        if (hipFuncSetAttribute((const void*)mega, hipFuncAttributeMaxDynamicSharedMemorySize, LDS_BYTES) != hipSuccess) { fprintf(stderr, "kernel_launch: hipFuncSetAttribute failed\n"); grid = -1; return; }
        if (hipOccupancyMaxActiveBlocksPerMultiprocessor(&per_cu, (const void*)mega, 512, LDS_BYTES) != hipSuccess || per_cu < 1) fprintf(stderr, "kernel_launch: occupancy query reports %d\n", per_cu);
        (void)hipGetLastError();
        if (cus < 256) { fprintf(stderr, "kernel_launch: %d CUs; this kernel is dealt for 256 resident workgroups: nothing launched\n", cus); grid = -1; return; }
        grid = 256;
    }
    if (grid < 0) return;
    (void)hipMemsetAsync((char*)d_ws + WS_CTL, 0, CTL_BYTES, stream);
    Params p{};
    const float** f = (const float**)&p;
    for (int i = 0; i < 25; ++i) f[i] = (const float*)d_in[i];
    p.out = (float*)d_out; p.ws = (unsigned char*)d_ws;
    p.ph_lo = 0; p.ph_hi = N_PHASES;
    hipLaunchKernelGGL(mega, dim3(grid), dim3(512), LDS_BYTES, stream, p);
}
#endif
```
